# Optimizing an MI355X kernel written in HIP

```python
import math
import jax, jax.numpy as jnp
from jax import lax
import numpy as np

D_MODEL = 2048
BATCH = 2
SEQ = 16384
DEPTH = 1

CTX_LEN = 256
GRID_W = 64

GLA_HEADS = 4
GLA_V_WIDTH = D_MODEL // 2
GLA_K_WIDTH = GLA_V_WIDTH // 2
GLA_HEAD_K = GLA_K_WIDTH // GLA_HEADS
GLA_HEAD_V = GLA_V_WIDTH // GLA_HEADS
GLA_GATE_RANK = 16
GLA_GATE_TEMP = 16.0
GLA_CHUNK = 64

HY_WIDTH = D_MODEL // 2
HY_EMB_DIM = 33
HY_FILTER_HIDDEN = 64
HY_N_INNER = 2
HY_FAST_DECAY = 0.3
HY_SLOW_DECAY = 1.5
HY_DECAY_TARGET = 1e-2

FFN_HIDDEN = ((8 * D_MODEL // 3 + 255) // 256) * 256

NORM_EPS = 1e-6

IN_SIZES = (GLA_K_WIDTH, GLA_K_WIDTH, GLA_V_WIDTH, GLA_GATE_RANK, GLA_GATE_RANK,
            GLA_V_WIDTH, 3 * HY_WIDTH, 2 * D_MODEL)
IN_WIDTH = sum(IN_SIZES)
IN_OFFSETS = tuple(sum(IN_SIZES[:i + 1]) for i in range(len(IN_SIZES) - 1))
CTX_COL_START = IN_SIZES[0]
CTX_COL_END = sum(IN_SIZES[:5])

kernel_name = "hybrid_gla_hyena_dit_layer"


def rmsnorm(x, w):
    xf = x.astype(jnp.float32)
    y = xf * lax.rsqrt(jnp.mean(xf * xf, axis=-1, keepdims=True) + NORM_EPS)
    return (y * w.astype(jnp.float32)).astype(x.dtype)


def modulation(cond, w_ada, b_ada):
    m = jax.nn.silu(cond) @ w_ada + b_ada
    return jnp.split(m, 6, axis=-1)


def gla_log_decay(lr, wg, bg):
    z = (lr @ wg + bg).astype(jnp.float32)
    la = jax.nn.log_sigmoid(z) / GLA_GATE_TEMP
    return la.reshape(lr.shape[0], lr.shape[1], GLA_HEADS, GLA_HEAD_K)


def gla_chunked(q, k, v, la, s0):
    B_, L, H, DK = q.shape
    DV = v.shape[-1]
    C = GLA_CHUNK
    N = L // C
    f32 = jnp.float32
    q = q.astype(f32).reshape(B_, N, C, H, DK)
    k = k.astype(f32).reshape(B_, N, C, H, DK)
    v = v.astype(f32).reshape(B_, N, C, H, DV)
    b = jnp.cumsum(la.reshape(B_, N, C, H, DK), axis=2)
    b_ref = b[:, :, C // 2 - 1:C // 2]
    b_last = b[:, :, -1:]
    scores = jnp.einsum('bnihd,bnjhd->bnhij', q * jnp.exp(b - b_ref), k * jnp.exp(b_ref - b))
    mask = jnp.tril(jnp.ones((C, C), dtype=bool))
    scores = jnp.where(mask, scores, 0.0)
    o_intra = jnp.einsum('bnhij,bnjhe->bnihe', scores, v)
    q_inter = q * jnp.exp(b)
    k_state = k * jnp.exp(b_last - b)
    decay_state = jnp.exp(b_last[:, :, 0])

    def step(s, xs):
        qc, kc, vc, dc = xs
        o = jnp.einsum('bihd,bhde->bihe', qc, s)
        s = dc[..., None] * s + jnp.einsum('bjhd,bjhe->bhde', kc, vc)
        return s, o

    xs = tuple(jnp.moveaxis(t, 1, 0) for t in (q_inter, k_state, v, decay_state))
    _, o_inter = lax.scan(step, s0, xs)
    o = o_intra + jnp.moveaxis(o_inter, 0, 1)
    return o.reshape(B_, L, H, DV)


def gla_final_state(k, v, la):
    b = jnp.cumsum(la, axis=1)
    w = jnp.exp(b[:, -1:] - b)
    return jnp.einsum('blhd,blhe->bhde', k.astype(jnp.float32) * w, v.astype(jnp.float32))


def short_conv3(u, w, b, grid_w):
    B_, L, C = u.shape
    if grid_w is None:
        ur = u
    else:
        rows = L // grid_w
        ur = u.reshape(B_, rows, grid_w, C)
    pad = [(0, 0)] * (ur.ndim - 2) + [(1, 1), (0, 0)]
    up = jnp.pad(ur, pad)
    y = up[..., :-2, :] * w[0] + up[..., 1:-1, :] * w[1] + up[..., 2:, :] * w[2] + b
    return y.reshape(B_, L, C)


def hyena_filters(L, emb_w, emb_b, mlp_w, mlp_b, freq, out_w):
    f32 = jnp.float32
    t = jnp.linspace(0.0, 1.0, L, dtype=f32)[:, None]
    bands = (HY_EMB_DIM - 1) // 2
    w = (2.0 * math.pi / L) * jnp.arange(L, dtype=f32)[:, None]
    fr = jnp.linspace(1e-4, bands - 1, bands, dtype=f32)[None, :]
    z = jnp.concatenate([t, jnp.cos(fr * w), -jnp.sin(fr * w)], axis=-1)
    freq = freq.astype(f32)
    hdn = jnp.sin(freq[0] * (z @ emb_w.astype(f32) + emb_b.astype(f32)))
    for i in range(HY_N_INNER):
        hdn = jnp.sin(freq[i + 1] * (hdn @ mlp_w[i].astype(f32) + mlp_b[i].astype(f32)))
    h = (hdn @ out_w.astype(f32)).reshape(L, 2, HY_WIDTH)
    deltas = jnp.abs(jnp.linspace(math.log(HY_FAST_DECAY) / HY_DECAY_TARGET,
                                  math.log(HY_SLOW_DECAY) / HY_DECAY_TARGET,
                                  HY_WIDTH, dtype=f32))
    h = h * jnp.exp(-t * deltas)[:, None, :]
    return h[:, 0], h[:, 1]


def long_conv_bidir(u, h_fwd, h_bwd, skip):
    L = u.shape[1]
    k_full = jnp.concatenate([h_fwd, jnp.zeros_like(h_fwd[:1]), h_bwd[:0:-1]], axis=0)
    k_f = jnp.fft.rfft(k_full, axis=0)
    u_f = jnp.fft.rfft(u, n=2 * L, axis=1)
    y = jnp.fft.irfft(u_f * k_f[None], n=2 * L, axis=1)[:, :L]
    return y + u * skip.astype(jnp.float32)


def hyena_branch(zh, grid_w, short_w, short_b, emb_w, emb_b, mlp_w, mlp_b, freq, out_w, skip):
    L = zh.shape[1]
    u = short_conv3(zh, short_w, short_b, grid_w)
    x0, x1, v = jnp.split(u, 3, axis=-1)
    h_fwd, h_bwd = hyena_filters(L, emb_w, emb_b, mlp_w, mlp_b, freq, out_w)
    y = long_conv_bidir((v * x1).astype(jnp.float32), h_fwd, h_bwd, skip)
    return (y * x0.astype(jnp.float32)).astype(zh.dtype)


def mixer(h, s0_f, s0_b, grid_w, p):
    (w_in, wg_f, bg_f, wg_b, bg_b, gla_norm, short_w, short_b, emb_w, emb_b,
     mlp_w, mlp_b, freq, out_w, hy_skip, p_gla, p_hy, w_out) = p
    B_, L, _ = h.shape
    z = h @ w_in
    q, k, v, lr_f, lr_b, g, zh, mg = jnp.split(z, IN_OFFSETS, axis=-1)
    q = q.reshape(B_, L, GLA_HEADS, GLA_HEAD_K) * (GLA_HEAD_K ** -0.5)
    k = k.reshape(B_, L, GLA_HEADS, GLA_HEAD_K)
    v = v.reshape(B_, L, GLA_HEADS, GLA_HEAD_V)
    la_f = gla_log_decay(lr_f, wg_f, bg_f)
    la_b = gla_log_decay(lr_b, wg_b, bg_b)
    fl = lambda t: jnp.flip(t, axis=1)
    o = gla_chunked(q, k, v, la_f, s0_f) + fl(gla_chunked(fl(q), fl(k), fl(v), fl(la_b), s0_b))
    o = rmsnorm(o, gla_norm).reshape(B_, L, GLA_V_WIDTH)
    o = (o * jax.nn.silu(g.astype(jnp.float32))).astype(h.dtype)
    y_hy = hyena_branch(zh, grid_w, short_w, short_b, emb_w, emb_b, mlp_w, mlp_b, freq, out_w, hy_skip)
    gate_a, gate_b = jnp.split(mg, 2, axis=-1)
    merged = jax.nn.sigmoid(gate_a) * (o @ p_gla) + jax.nn.sigmoid(gate_b) * (y_hy @ p_hy)
    return merged @ w_out


def context_states(hc, w_in, wg_f, bg_f, wg_b, bg_b):
    B_, L, _ = hc.shape
    z = hc @ w_in[:, CTX_COL_START:CTX_COL_END]
    k, v, lr_f, lr_b = jnp.split(z, (GLA_K_WIDTH, GLA_K_WIDTH + GLA_V_WIDTH,
                                     GLA_K_WIDTH + GLA_V_WIDTH + GLA_GATE_RANK), axis=-1)
    k = k.reshape(B_, L, GLA_HEADS, GLA_HEAD_K)
    v = v.reshape(B_, L, GLA_HEADS, GLA_HEAD_V)
    la_f = gla_log_decay(lr_f, wg_f, bg_f)
    la_b = gla_log_decay(lr_b, wg_b, bg_b)
    s_f = gla_final_state(k, v, la_f)
    s_b = gla_final_state(jnp.flip(k, 1), jnp.flip(v, 1), jnp.flip(la_b, 1))
    return s_f, s_b


def swiglu(h, wg, wu, wd):
    return (jax.nn.silu(h @ wg) * (h @ wu)) @ wd


def setup_inputs(seed: int = 0) -> dict:
    key = jax.random.key(seed)
    ks = iter(jax.random.split(key, 64))
    f32 = jnp.float32

    def nrm(shape, scale):
        return scale * jax.random.normal(next(ks), shape, f32)

    def gain(shape):
        return 1.0 + nrm(shape, 0.02)

    D, FH = D_MODEL, HY_FILTER_HIDDEN
    return {
        "x": nrm((BATCH, SEQ, D), 1.0),
        "c": nrm((BATCH, D), 1.0),
        "ctx": nrm((BATCH, CTX_LEN, D), 1.0),
        "c_ctx": nrm((D,), 1.0),
        "w_ada": nrm((DEPTH, D, 6 * D), 0.5 * D ** -0.5),
        "b_ada": nrm((DEPTH, 6 * D), 0.02),
        "norm_pre_mix": gain((DEPTH, D)),
        "norm_post_mix": gain((DEPTH, D)),
        "norm_pre_ffn": gain((DEPTH, D)),
        "norm_post_ffn": gain((DEPTH, D)),
        "w_in": nrm((DEPTH, D, IN_WIDTH), D ** -0.5),
        "gla_wg_f": nrm((DEPTH, GLA_GATE_RANK, GLA_K_WIDTH), GLA_GATE_RANK ** -0.5),
        "gla_bg_f": nrm((DEPTH, GLA_K_WIDTH), 0.1),
        "gla_wg_b": nrm((DEPTH, GLA_GATE_RANK, GLA_K_WIDTH), GLA_GATE_RANK ** -0.5),
        "gla_bg_b": nrm((DEPTH, GLA_K_WIDTH), 0.1),
        "gla_norm": gain((DEPTH, GLA_HEAD_V)),
        "hy_short_w": nrm((DEPTH, 3, 3 * HY_WIDTH), 3 ** -0.5),
        "hy_short_b": nrm((DEPTH, 3 * HY_WIDTH), 0.02),
        "hy_emb_w": nrm((DEPTH, HY_EMB_DIM, FH), HY_EMB_DIM ** -0.5),
        "hy_emb_b": nrm((DEPTH, FH), 0.1),
        "hy_mlp_w": nrm((DEPTH, HY_N_INNER, FH, FH), FH ** -0.5),
        "hy_mlp_b": nrm((DEPTH, HY_N_INNER, FH), 0.1),
        "hy_freq": gain((DEPTH, HY_N_INNER + 1, FH)),
        "hy_out_w": nrm((DEPTH, FH, 2 * HY_WIDTH), 0.02 * FH ** -0.5),
        "hy_skip": nrm((DEPTH, HY_WIDTH), 0.1),
        "p_gla": nrm((DEPTH, GLA_V_WIDTH, D), GLA_V_WIDTH ** -0.5),
        "p_hy": nrm((DEPTH, HY_WIDTH, D), HY_WIDTH ** -0.5),
        "w_out": nrm((DEPTH, D, D), D ** -0.5),
        "ffn_gate": nrm((DEPTH, D, FFN_HIDDEN), D ** -0.5),
        "ffn_up": nrm((DEPTH, D, FFN_HIDDEN), D ** -0.5),
        "ffn_down": nrm((DEPTH, FFN_HIDDEN, D), FFN_HIDDEN ** -0.5),
    }


def reference(x, c, ctx, c_ctx, w_ada, b_ada, norm_pre_mix, norm_post_mix, norm_pre_ffn,
              norm_post_ffn, w_in, gla_wg_f, gla_bg_f, gla_wg_b, gla_bg_b, gla_norm,
              hy_short_w, hy_short_b, hy_emb_w, hy_emb_b, hy_mlp_w, hy_mlp_b, hy_freq,
              hy_out_w, hy_skip, p_gla, p_hy, w_out, ffn_gate, ffn_up, ffn_down):
    for layer in range(DEPTH):
        last = layer == DEPTH - 1
        mix_p = (w_in[layer], gla_wg_f[layer], gla_bg_f[layer], gla_wg_b[layer], gla_bg_b[layer],
                 gla_norm[layer], hy_short_w[layer], hy_short_b[layer], hy_emb_w[layer],
                 hy_emb_b[layer], hy_mlp_w[layer], hy_mlp_b[layer], hy_freq[layer],
                 hy_out_w[layer], hy_skip[layer], p_gla[layer], p_hy[layer], w_out[layer])
        sh1, sc1, g1, sh2, sc2, g2 = modulation(c[:, None, :], w_ada[layer], b_ada[layer])
        csh1, csc1, cg1, csh2, csc2, cg2 = modulation(c_ctx, w_ada[layer], b_ada[layer])

        hc = rmsnorm(ctx, norm_pre_mix[layer]) * (1.0 + csc1) + csh1
        s_f, s_b = context_states(hc, w_in[layer], gla_wg_f[layer], gla_bg_f[layer],
                                  gla_wg_b[layer], gla_bg_b[layer])

        hx = rmsnorm(x, norm_pre_mix[layer]) * (1.0 + sc1) + sh1
        x = x + g1 * rmsnorm(mixer(hx, s_f, s_b, GRID_W, mix_p), norm_post_mix[layer])
        hx = rmsnorm(x, norm_pre_ffn[layer]) * (1.0 + sc2) + sh2
        x = x + g2 * rmsnorm(swiglu(hx, ffn_gate[layer], ffn_up[layer], ffn_down[layer]),
                             norm_post_ffn[layer])

        if not last:
            zero_s = jnp.zeros((ctx.shape[0], GLA_HEADS, GLA_HEAD_K, GLA_HEAD_V), jnp.float32)
            ctx = ctx + cg1 * rmsnorm(mixer(hc, zero_s, zero_s, None, mix_p), norm_post_mix[layer])
            hc2 = rmsnorm(ctx, norm_pre_ffn[layer]) * (1.0 + csc2) + csh2
            ctx = ctx + cg2 * rmsnorm(swiglu(hc2, ffn_gate[layer], ffn_up[layer], ffn_down[layer]),
                                      norm_post_ffn[layer])
    return x
```

```cpp
#include <hip/hip_runtime.h>
#include <hip/hip_cooperative_groups.h>
#include <cstdio>
namespace cg = cooperative_groups;

#ifndef SINGLE_LAUNCH
#define SINGLE_LAUNCH 1
#endif

#define DI __device__ __forceinline__
#define LAS __attribute__((address_space(3)))
typedef unsigned short bf16_t;
typedef short bf16x8 __attribute__((ext_vector_type(8)));
typedef float f32x2 __attribute__((ext_vector_type(2)));
typedef float f32x4 __attribute__((ext_vector_type(4)));
typedef float f32x16 __attribute__((ext_vector_type(16)));
typedef unsigned u32x2 __attribute__((ext_vector_type(2)));
typedef unsigned u32x4 __attribute__((ext_vector_type(4)));
typedef __bf16 bfv2 __attribute__((ext_vector_type(2)));

constexpr int T = 32768, TC = 33280, SEQ = 16384, D = 2048;
constexpr size_t MiB = 1048576;
constexpr int SMEM_BYTES = 147456;
constexpr int NTHREADS = 512;

constexpr size_t OFF_MOD = 0, OFF_HDN = 1 * MiB, OFF_LR = 4 * MiB, OFF_DD = 10 * MiB;
constexpr size_t OFF_HX = 16 * MiB, OFF_WIN = 146 * MiB, OFF_HT = 187 * MiB, OFF_QKV = 315 * MiB, OFF_G = 445 * MiB, OFF_ZH = 509 * MiB;
constexpr size_t OFF_O = 701 * MiB, OFF_ZC = 829 * MiB, OFF_VT = 957 * MiB, OFF_QI = 16 * MiB, OFF_KST = 81 * MiB;
constexpr size_t OFF_FFTS = 315 * MiB, OFF_AM = 16 * MiB, OFF_W2 = 315 * MiB, OFF_MERGED = 187 * MiB, OFF_MIX = 445 * MiB;
constexpr size_t OFF_HX2 = 187 * MiB, OFF_HID = 573 * MiB, OFF_FFN = 16 * MiB;
constexpr size_t OFF_SLOC = 146 * MiB, OFF_DSEG = 180 * MiB;
constexpr size_t OFF_OFB = 187 * MiB;
constexpr size_t WS_NEEDED = 1022 * MiB;
constexpr size_t W2_PM = 0, W2_WOUT = 8388608, W2_WGU = 16777216, W2_WD = 16777216 + 46137344;

struct P {
  const float *x, *c, *ctx, *c_ctx, *w_ada, *b_ada, *n_pre_mix, *n_post_mix, *n_pre_ffn, *n_post_ffn, *w_in;
  const float *wg_f, *bg_f, *wg_b, *bg_b, *gla_norm, *short_w, *short_b, *emb_w, *emb_b, *mlp_w, *mlp_b, *freq, *out_w, *skip;
  const float *p_gla, *p_hy, *w_out, *ffn_gate, *ffn_up, *ffn_down;
  float* out; char* ws;
};

extern __shared__ __attribute__((aligned(16))) char g_smem[];

DI unsigned pk2(float lo, float hi) { f32x2 v = {lo, hi}; bfv2 r = __builtin_convertvector(v, bfv2); return __builtin_bit_cast(unsigned, r); }
DI bf16_t f2bf(float f) { __bf16 h = (__bf16)f; return __builtin_bit_cast(bf16_t, h); }
DI float bf2f(bf16_t h) { return __uint_as_float(((unsigned)h) << 16); }
DI float bflo(unsigned u) { return __uint_as_float(u << 16); }
DI float bfhi(unsigned u) { return __uint_as_float(u & 0xffff0000u); }
DI float wave_sum(float v) { for (int m = 32; m >= 1; m >>= 1) v += __shfl_xor(v, m, 64); return v; }
DI float sigmoidf_(float v) { return 1.f / (1.f + __expf(-v)); }
#define MFMA16(a, b, c) __builtin_amdgcn_mfma_f32_16x16x32_bf16((a), (b), (c), 0, 0, 0)
#define MFMA32(a, b, c) __builtin_amdgcn_mfma_f32_32x32x16_bf16((a), (b), (c), 0, 0, 0)

DI void wconv(const float* __restrict__ src, int ld, int K, int col0, int ncols, bf16_t* __restrict__ dst, int dstld, int drow0, int mode, int bid, int nb) {
  float* t = (float*)g_smem;
  const int ntn = ncols / 32, ntk = K / 64, nt = ntn * ntk, tid = threadIdx.x;
  for (int it = bid; it < nt; it += nb) {
    const int tn = it % ntn, tk = it / ntn;
#pragma unroll
    for (int q = 0; q < 4; ++q) { int e = tid + 512 * q; int r = e >> 5, c = e & 31; t[r * 33 + c] = src[(size_t)(tk * 64 + r) * ld + col0 + tn * 32 + c]; }
    __syncthreads();
    { int n = tid >> 4, kk = (tid & 15) * 4; int cs = tn * 32 + n;
      int drow = mode == 0 ? drow0 + cs : ((cs >> 7) * 256 + drow0 + (cs & 127));
      u32x2 v; v.x = pk2(t[(kk) * 33 + n], t[(kk + 1) * 33 + n]); v.y = pk2(t[(kk + 2) * 33 + n], t[(kk + 3) * 33 + n]);
      *(u32x2*)(dst + (size_t)drow * dstld + tk * 64 + kk) = v; }
    __syncthreads();
  }
}

DI void phase_prep(const P& p, int bid, int nb) {
  const int tid = threadIdx.x;
  {
    float* sl = (float*)(g_smem + 16384); float* red = sl + 3 * 2048;
    float* MOD = (float*)(p.ws + OFF_MOD);
    for (int it = bid; it < 192; it += nb) {
      for (int e = tid; e < 3 * 2048; e += 512) { int r = e >> 11, k = e & 2047; float v = r < 2 ? p.c[r * 2048 + k] : p.c_ctx[k]; sl[e] = v / (1.f + __expf(-v)); }
      __syncthreads();
      const int cgp = tid & 15, kg = tid >> 4; const int n0 = it * 64 + cgp * 4;
      f32x4 a0 = {0, 0, 0, 0}, a1 = a0, a2 = a0;
#pragma unroll 8
      for (int kk = 0; kk < 64; ++kk) { int k = kg * 64 + kk; f32x4 w = *(const f32x4*)(p.w_ada + (size_t)k * 12288 + n0); a0 += w * sl[k]; a1 += w * sl[2048 + k]; a2 += w * sl[4096 + k]; }
      *(f32x4*)(red + (kg * 3 + 0) * 64 + cgp * 4) = a0; *(f32x4*)(red + (kg * 3 + 1) * 64 + cgp * 4) = a1; *(f32x4*)(red + (kg * 3 + 2) * 64 + cgp * 4) = a2;
      __syncthreads();
      if (tid < 192) { int r = tid >> 6, c = tid & 63; float s = p.b_ada[it * 64 + c];
#pragma unroll 8
        for (int k2 = 0; k2 < 32; ++k2) s += red[(k2 * 3 + r) * 64 + c]; MOD[r * 12288 + it * 64 + c] = s; }
      __syncthreads();
    }
  }
  {
    float* zb = (float*)(g_smem + 16384); float* ha = zb + 8 * 36; float* hb = ha + 8 * 64;
    bf16_t* HDN = (bf16_t*)(p.ws + OFF_HDN);
    const int tl = tid >> 6, j = tid & 63;
    for (int it = bid; it < 2048; it += nb) {
      const int t = it * 8 + tl;
      if (j < 33) { float v; if (j == 0) v = (float)t * (1.f / 16383.f); else { int i = (j - 1) & 15; float fr = 1e-4f + (float)i * ((15.f - 1e-4f) / 15.f); float turns = fr * ((float)t * (1.f / 16384.f)); turns -= floorf(turns);
          v = (j <= 16) ? __builtin_amdgcn_cosf(turns) : -__builtin_amdgcn_sinf(turns); } zb[tl * 36 + j] = v; }
      __syncthreads();
      float acc = p.emb_b[j];
#pragma unroll 3
      for (int i = 0; i < 33; ++i) acc += zb[tl * 36 + i] * p.emb_w[i * 64 + j];
      ha[tl * 64 + j] = __sinf(p.freq[j] * acc);
      __syncthreads();
      acc = p.mlp_b[j];
#pragma unroll 8
      for (int i = 0; i < 64; ++i) acc += ha[tl * 64 + i] * p.mlp_w[i * 64 + j];
      hb[tl * 64 + j] = __sinf(p.freq[64 + j] * acc);
      __syncthreads();
      acc = p.mlp_b[64 + j];
#pragma unroll 8
      for (int i = 0; i < 64; ++i) acc += hb[tl * 64 + i] * p.mlp_w[4096 + i * 64 + j];
      HDN[(size_t)t * 64 + j] = f2bf(__sinf(p.freq[128 + j] * acc));
      __syncthreads();
    }
  }
}

DI void phase_pre(const P& p, int bid, int nb) {
  const int tid = threadIdx.x, wid = tid >> 6, lane = tid & 63;
  const float* MOD = (const float*)(p.ws + OFF_MOD);
  bf16_t* HX = (bf16_t*)(p.ws + OFF_HX);
  for (int row = bid * 8 + wid; row < TC; row += nb * 8) {
    const float* src; int mrow;
    if (row < T) { src = p.x + (size_t)row * D; mrow = row >> 14; } else { src = p.ctx + (size_t)(row - T) * D; mrow = 2; }
    f32x4 v[8]; float ss = 0.f;
#pragma unroll
    for (int q = 0; q < 8; ++q) { v[q] = *(const f32x4*)(src + q * 256 + lane * 4); ss += v[q].x * v[q].x + v[q].y * v[q].y + v[q].z * v[q].z + v[q].w * v[q].w; }
    ss = wave_sum(ss); const float rstd = rsqrtf(ss * (1.f / 2048.f) + 1e-6f);
    const float* sh = MOD + mrow * 12288; const float* sc = sh + 2048;
#pragma unroll
    for (int q = 0; q < 8; ++q) { int idx = q * 256 + lane * 4; f32x4 w = *(const f32x4*)(p.n_pre_mix + idx), s1 = *(const f32x4*)(sc + idx), h1 = *(const f32x4*)(sh + idx);
      f32x4 y = v[q] * rstd * w * (1.f + s1) + h1; u32x2 o; o.x = pk2(y.x, y.y); o.y = pk2(y.z, y.w); *(u32x2*)(HX + (size_t)row * D + idx) = o; }
  }
  {
    const int fr = lane & 15, fq = lane >> 4;
    const bf16_t* HDN = (const bf16_t*)(p.ws + OFF_HDN); float* HT = (float*)(p.ws + OFF_HT);
    for (int id = bid * 8 + wid; id < 128 * 64; id += nb * 8) {
      const int mt = id & 127, ng = id >> 7; const int ch = mt * 16 + fr;
      bf16x8 a[2];
#pragma unroll
      for (int s = 0; s < 2; ++s)
#pragma unroll
        for (int i = 0; i < 8; ++i) a[s][i] = (short)f2bf(p.out_w[(size_t)(s * 32 + fq * 8 + i) * 2048 + ch]);
      const float lo = -120.39728043259361f, hi = 40.546510810816436f;
      const float delta = fabsf(lo + (float)(ch & 1023) * ((hi - lo) / 1023.f));
      for (int q = 0; q < 16; ++q) {
        const int n0 = (ng * 16 + q) * 16;
        bf16x8 b0 = *(const bf16x8*)(HDN + (size_t)(n0 + fr) * 64 + fq * 8), b1 = *(const bf16x8*)(HDN + (size_t)(n0 + fr) * 64 + 32 + fq * 8);
        f32x4 acc = {0, 0, 0, 0};
        acc = MFMA16(b0, a[0], acc); acc = MFMA16(b1, a[1], acc);
#pragma unroll
        for (int jj = 0; jj < 4; ++jj) { float tl = (float)(n0 + 4 * fq + jj) * (1.f / 16383.f); acc[jj] *= __expf(-tl * delta); }
        *(f32x4*)(HT + (size_t)ch * 16384 + n0 + 4 * fq) = acc;
      }
    }
  }
  bf16_t* WIN = (bf16_t*)(p.ws + OFF_WIN);
#pragma unroll 1
  for (int job = 0; job < 7; ++job) {
    int col0, ncols, drow0, mode = 0;
    switch (job) { case 0: col0 = 0; ncols = 2048; drow0 = 0; break; case 1: col0 = 2080; ncols = 1024; drow0 = 2048; break;
      case 2: col0 = 3104; ncols = 1024; drow0 = 3072; break;
      case 3: col0 = 4128; ncols = 1024; drow0 = 4096; mode = 1; break;
      case 4: col0 = 5152; ncols = 1024; drow0 = 4096 + 128; mode = 1; break;
      case 5: col0 = 6176; ncols = 4096; drow0 = 6144; break; default: col0 = 2048; ncols = 32; drow0 = 10240; break; }
    wconv(p.w_in, 10272, 2048, col0, ncols, WIN, 2048, drow0, mode, bid, nb);
  }
  for (size_t e = (size_t)bid * 512 + tid; e < (size_t)224 * 2048 / 8; e += (size_t)nb * 512) ((u32x4*)(WIN + (size_t)10272 * 2048))[e] = (u32x4){0u, 0u, 0u, 0u};
}

DI int lds_byte(int r, int c) { int st = (r >> 4) * 2 + (c >> 5), rr = r & 15, cc = c & 31, ob = rr * 64 + cc * 2; return st * 1024 + (ob ^ (((ob >> 9) & 1) << 5)); }
DI void stage_rc(int b, int& R, int& C) { int st = b / 1024, sb = b % 1024, swz = sb ^ (((sb >> 9) & 1) << 5); R = (st >> 1) * 16 + swz / 64; C = (st & 1) * 32 + (swz % 64) / 2; }
DI int perm32(int rho) { const int n = rho >> 4, i = rho & 15; return 8 * (i >> 2) + 4 * n + (i & 3); }
DI void unit_order(int L, int nM, int nN, int& pm, int& pn) {
  const int nwg = nM * nN; int wgid = L;
  { const int q = nwg / 8, r = nwg % 8, xcd = wgid % 8, off = wgid / 8; wgid = (xcd < r ? xcd * (q + 1) : r * (q + 1) + (xcd - r) * q) + off; }
  const int nig = 8 * nN, gid = wgid / nig, fm = gid * 8, gsz = (nM - fm) < 8 ? (nM - fm) : 8;
  pm = fm + ((wgid % nig) % gsz); pn = (wgid % nig) / gsz;
}

struct Unit { const char* a; const char* b; int pm, pn, tag; };
template <class Sched, class Epi>
DI void gemm_stream(const long lda, const long ldb, const int K, const Sched& S, const Epi& E) {
  LAS unsigned char* lds = (LAS unsigned char*)g_smem;
  constexpr int HTB = 128 * 64 * 2;
  const int tid = threadIdx.x, wid = __builtin_amdgcn_readfirstlane(tid >> 6), lane = tid & 63, wr = wid >> 2, wc = wid & 3, fr = lane & 15, fq = lane >> 4;
  const int nt = K / 64;
  unsigned voffA[2], voffB[2];
#pragma unroll
  for (int i = 0; i < 2; ++i) { int R, C; stage_rc(tid * 16 + i * 8192, R, C); const int Rb = (R & ~31) + perm32(R & 31);
    voffA[i] = (unsigned)(R * (int)lda + C) * 2u; voffB[i] = (unsigned)(Rb * (int)ldb + C) * 2u; }
  const size_t kstep = 128, hstepA = (size_t)128 * lda * 2, hstepB = (size_t)128 * ldb * 2;
  const unsigned ldsw = (unsigned)wid * 1024u;
  const int aoff = lds_byte(wr * 64 + fr, fq * 8), boff = lds_byte(wc * 32 + fr, fq * 8);
#define G_SA(b, h) (((b) * 2 + (h)) * HTB)
#define G_SB(b, h) ((4 + (b) * 2 + (h)) * HTB)
#define G_STAGE(bufoff, gbase, voff) do { _Pragma("unroll") for (int _i = 0; _i < 2; ++_i) \
    __builtin_amdgcn_global_load_lds((const unsigned*)((const char*)(gbase) + (voff)[_i]), (LAS unsigned*)(lds + (bufoff) + ldsw + _i * 8192), 16, 0, 0); } while (0)
#define G_LDA(dst, b, h) do { _Pragma("unroll") for (int m = 0; m < 4; ++m) _Pragma("unroll") for (int k = 0; k < 2; ++k) dst[m][k] = *(const LAS bf16x8*)(lds + G_SA(b, h) + aoff + m * 2048 + k * 1024); } while (0)
#define G_LDB(dst, b, h) do { _Pragma("unroll") for (int n = 0; n < 2; ++n) _Pragma("unroll") for (int k = 0; k < 2; ++k) dst[n][k] = *(const LAS bf16x8*)(lds + G_SB(b, h) + boff + n * 2048 + k * 1024); } while (0)
#define G_MMA(ai, bj, At_, Bt_) do { __builtin_amdgcn_s_setprio(1); _Pragma("unroll") for (int m = 0; m < 4; ++m) _Pragma("unroll") for (int n = 0; n < 2; ++n) _Pragma("unroll") for (int k = 0; k < 2; ++k) \
    acc[ai][bj][m][n] = MFMA16(Bt_[n][k], At_[m][k], acc[ai][bj][m][n]); __builtin_amdgcn_s_setprio(0); } while (0)
#define G_WAIT_V(n) asm volatile("s_waitcnt vmcnt(" #n ")" ::: "memory")
#define G_WAIT_L(n) asm volatile("s_waitcnt lgkmcnt(" #n ")" ::: "memory")
#define G_BAR __builtin_amdgcn_s_barrier()
#define G_SCHED __builtin_amdgcn_sched_barrier(0)
  Unit cur, nxt; int ui = 0;
  if (!S.next(0, cur)) return;
  f32x4 acc[2][2][4][2];
#pragma unroll
  for (int a = 0; a < 2; ++a)
#pragma unroll
    for (int b = 0; b < 2; ++b)
#pragma unroll
      for (int m = 0; m < 4; ++m)
#pragma unroll
        for (int n = 0; n < 2; ++n) acc[a][b][m][n] = (f32x4){0.f, 0.f, 0.f, 0.f};
  bf16x8 At[4][2], B0[2][2], B1[2][2];
  const char* cA = cur.a; const char* cB = cur.b;
  G_WAIT_V(0);
  G_STAGE(G_SB(0, 0), cB, voffB); G_STAGE(G_SA(0, 0), cA, voffA); G_STAGE(G_SB(0, 1), cB + hstepB, voffB); G_STAGE(G_SA(0, 1), cA + hstepA, voffA);
  if (wr == 1) G_BAR;
  G_WAIT_V(4); G_BAR;
  G_STAGE(G_SB(1, 0), cB + kstep, voffB); G_STAGE(G_SA(1, 0), cA + kstep, voffA); G_STAGE(G_SB(1, 1), cB + hstepB + kstep, voffB);
  G_WAIT_V(6); G_BAR;
  for (;;) {
    const bool has_next = S.next(ui + 1, nxt);
    const char* nA = has_next ? nxt.a : cA; const char* nB = has_next ? nxt.b : cB;
#pragma unroll 1
    for (int t = 0; t < nt; t += 2) {
      const bool last = (t == nt - 2);
      const char* a1 = cA + (size_t)(t + 1) * kstep;
      const char* a2 = last ? nA : cA + (size_t)(t + 2) * kstep; const char* b2 = last ? nB : cB + (size_t)(t + 2) * kstep;
      const char* a3 = a2 + kstep; const char* b3 = b2 + kstep;
      G_LDB(B0, 0, 0); G_SCHED; G_LDA(At, 0, 0); G_STAGE(G_SA(1, 1), a1 + hstepA, voffA);
      G_WAIT_L(8); G_BAR; G_WAIT_L(0); G_MMA(0, 0, At, B0); G_BAR; G_SCHED;
      G_LDB(B1, 0, 1); G_STAGE(G_SB(0, 0), b2, voffB);
      G_BAR; G_WAIT_L(0); G_MMA(0, 1, At, B1); G_BAR;
      G_LDA(At, 0, 1); G_STAGE(G_SA(0, 0), a2, voffA);
      G_BAR; G_WAIT_L(0); G_MMA(1, 0, At, B0); G_BAR; G_SCHED;
      G_STAGE(G_SB(0, 1), b2 + hstepB, voffB);
      G_WAIT_V(6); G_BAR; G_MMA(1, 1, At, B1); G_BAR;
      G_LDB(B0, 1, 0); G_SCHED; G_LDA(At, 1, 0); G_STAGE(G_SA(0, 1), a2 + hstepA, voffA);
      G_WAIT_L(8); G_BAR; G_WAIT_L(0); G_MMA(0, 0, At, B0); G_BAR; G_SCHED;
      G_LDB(B1, 1, 1); G_STAGE(G_SB(1, 0), b3, voffB);
      G_BAR; G_WAIT_L(0); G_MMA(0, 1, At, B1); G_BAR;
      G_LDA(At, 1, 1); G_STAGE(G_SA(1, 0), a3, voffA);
      G_BAR; G_WAIT_L(0); G_MMA(1, 0, At, B0); G_BAR; G_SCHED;
      G_STAGE(G_SB(1, 1), b3 + hstepB, voffB);
      G_WAIT_V(6); G_BAR; G_MMA(1, 1, At, B1); G_BAR;
    }
    E(acc, cur, wr, wc, fr, fq);
    if (!has_next) break;
    if (!(nxt.tag & 1)) {
#pragma unroll
      for (int a = 0; a < 2; ++a)
#pragma unroll
        for (int b = 0; b < 2; ++b)
#pragma unroll
          for (int m = 0; m < 4; ++m)
#pragma unroll
            for (int n = 0; n < 2; ++n) acc[a][b][m][n] = (f32x4){0.f, 0.f, 0.f, 0.f};
    }
    cur = nxt; cA = nA; cB = nB; ++ui;
  }
  G_WAIT_V(0);
  if (wr == 0) G_BAR;
  G_BAR;
}

struct GridSched {
  const bf16_t* A; const bf16_t* Bt; long lda, ldb; int nM, nN, bid, nb;
  DI bool next(int i, Unit& u) const { const int L = i * nb + bid; if (L >= nM * nN) return false; unit_order(L, nM, nN, u.pm, u.pn);
    u.a = (const char*)(A + (size_t)u.pm * 256 * lda); u.b = (const char*)(Bt + (size_t)u.pn * 256 * ldb); u.tag = 0; return true; }
};

DI void zero_acc(f32x4 (&acc)[2][2][4][2]) {
#pragma unroll
  for (int a = 0; a < 2; ++a)
#pragma unroll
    for (int b = 0; b < 2; ++b)
#pragma unroll
      for (int m = 0; m < 4; ++m)
#pragma unroll
        for (int n = 0; n < 2; ++n) acc[a][b][m][n] = (f32x4){0.f, 0.f, 0.f, 0.f};
}

template <int ACT>
DI void store_tile_bf16(const f32x4 (&acc)[2][2][4][2], bf16_t* dst, long ld, int brow, int col0, float scale, int wr, int wc, int fr, int fq) {
#pragma unroll
  for (int ai = 0; ai < 2; ++ai)
#pragma unroll
    for (int m = 0; m < 4; ++m) {
      bf16_t* rp = dst + (long)(brow + ai * 128 + wr * 64 + m * 16 + fr) * ld + col0 + wc * 32 + 8 * fq;
#pragma unroll
      for (int bj = 0; bj < 2; ++bj) {
        f32x4 v0 = acc[ai][bj][m][0], v1 = acc[ai][bj][m][1];
        if (ACT == 1) { v0 *= scale; v1 *= scale; }
        if (ACT == 2) {
#pragma unroll
          for (int j = 0; j < 4; ++j) { v0[j] = v0[j] * sigmoidf_(v0[j]); v1[j] = v1[j] * sigmoidf_(v1[j]); } }
        u32x4 w; w.x = pk2(v0[0], v0[1]); w.y = pk2(v0[2], v0[3]); w.z = pk2(v1[0], v1[1]); w.w = pk2(v1[2], v1[3]);
        *(u32x4*)(rp + bj * 128) = w;
      }
    }
}

struct Gemm1Sched { const bf16_t* A; const bf16_t* Bt; int bid, nb;
  DI bool next(int i, Unit& u) const { const int L = i * nb + bid; const int nmain = 128 * 41; if (L >= nmain + 18) return false;
    if (L < nmain) unit_order(L, 128, 41, u.pm, u.pn); else { int e = L - nmain; u.pm = 128 + e / 9; int c = e % 9; u.pn = c < 8 ? c : 40; }
    u.a = (const char*)(A + (size_t)u.pm * 256 * 2048); u.b = (const char*)(Bt + (size_t)u.pn * 256 * 2048); u.tag = 0; return true; } };
DI void phase_gemm1(const P& p, int bid, int nb) {
  const bf16_t* HX = (const bf16_t*)(p.ws + OFF_HX); const bf16_t* WIN = (const bf16_t*)(p.ws + OFF_WIN);
  bf16_t* QKV = (bf16_t*)(p.ws + OFF_QKV); bf16_t* G = (bf16_t*)(p.ws + OFF_G); bf16_t* ZH = (bf16_t*)(p.ws + OFF_ZH); bf16_t* MG = (bf16_t*)p.out;
  float* LR = (float*)(p.ws + OFF_LR);
  Gemm1Sched S{HX, WIN, bid, nb};
  auto E = [&](f32x4 (&acc)[2][2][4][2], const Unit& u, int wr, int wc, int fr, int fq) {
    const int brow = u.pm * 256, pn = u.pn;
    if (pn < 2) store_tile_bf16<1>(acc, QKV, 2048, brow, pn * 256, 0.08838834764831845f, wr, wc, fr, fq);
    else if (pn < 8) store_tile_bf16<0>(acc, QKV, 2048, brow, pn * 256, 1.f, wr, wc, fr, fq);
    else if (pn < 12) store_tile_bf16<2>(acc, G, 1024, brow, (pn - 8) * 256, 1.f, wr, wc, fr, fq);
    else if (pn < 16) store_tile_bf16<0>(acc, ZH, 1024, brow, (pn - 12) * 256, 1.f, wr, wc, fr, fq);
    else if (pn < 24) {
      const int lane = threadIdx.x & 63; const int cb = (pn - 16) * 128 + wc * 32 + 8 * fq;
      const int upsrc = (lane & ~15) | ((fr - 1) & 15), dnsrc = (lane & ~15) | ((fr + 1) & 15);
      float* ZCf = (float*)(p.ws + OFF_ZC);
#pragma unroll
      for (int n = 0; n < 2; ++n)
#pragma unroll
        for (int jj = 0; jj < 4; ++jj) { const int c = cb + 4 * n + jj;
          const float a0 = p.short_w[1024 + c], a1 = p.short_w[3072 + 1024 + c], a2 = p.short_w[6144 + 1024 + c], ab = p.short_b[1024 + c];
          const float v0 = p.short_w[2048 + c], v1 = p.short_w[3072 + 2048 + c], v2 = p.short_w[6144 + 2048 + c], vbias = p.short_b[2048 + c];
#pragma unroll
          for (int ai = 0; ai < 2; ++ai) { const int t0 = brow + ai * 128 + wr * 64; const int bb = t0 >> 14, tin = t0 & 16383;
            float xr[4], vr[4], xu[4], vu[4], xd[4], vd[4];
#pragma unroll
            for (int m = 0; m < 4; ++m) { xr[m] = acc[ai][0][m][n][jj]; vr[m] = acc[ai][1][m][n][jj];
              xu[m] = __shfl(xr[m], upsrc, 64); vu[m] = __shfl(vr[m], upsrc, 64); xd[m] = __shfl(xr[m], dnsrc, 64); vd[m] = __shfl(vr[m], dnsrc, 64); }
            float* zp = ZCf + ((size_t)bb * 1024 + c) * 16384 + tin + fr;
#pragma unroll
            for (int m = 0; m < 4; ++m) {
              const float xup = fr > 0 ? xu[m] : (m > 0 ? xu[m - 1] : 0.f), vup = fr > 0 ? vu[m] : (m > 0 ? vu[m - 1] : 0.f);
              const float xdn = fr < 15 ? xd[m] : (m < 3 ? xd[m + 1] : 0.f), vdn = fr < 15 ? vd[m] : (m < 3 ? vd[m + 1] : 0.f);
              const float ux = a0 * xup + a1 * xr[m] + a2 * xdn + ab, uv = v0 * vup + v1 * vr[m] + v2 * vdn + vbias;
              zp[16 * m] = ux * uv; } } }
    }
    else if (pn < 40) store_tile_bf16<0>(acc, MG, 4096, brow, (pn - 24) * 256, 1.f, wr, wc, fr, fq);
    else if (wc == 0) {
#pragma unroll
      for (int ai = 0; ai < 2; ++ai)
#pragma unroll
        for (int m = 0; m < 4; ++m) { float* rp = LR + (size_t)(brow + ai * 128 + wr * 64 + m * 16 + fr) * 32 + 8 * fq;
          *(f32x4*)(rp) = acc[ai][0][m][0]; *(f32x4*)(rp + 4) = acc[ai][0][m][1]; }
    }
  };
  gemm_stream(2048, 2048, 2048, S, E);
}

DI void phase_local(const P& p, int bid, int nb) {
  const int tid = threadIdx.x, wid = tid >> 6, lane = tid & 63, fr = lane & 15, fq = lane >> 4;
  float* bL = (float*)g_smem;
  bf16_t* Qs = (bf16_t*)(g_smem + 33280);
  bf16_t* Ks = Qs + 64 * 136;
  bf16_t* KT = Ks + 64 * 136;
  bf16_t* Pm = KT + 128 * 72;
  bf16_t* VTl = Pm + 64 * 136;
  float* tot = (float*)(VTl + 256 * 72);
  float* wgL = (float*)KT;
  const bf16_t* QKV = (const bf16_t*)(p.ws + OFF_QKV); const float* LR = (const float*)(p.ws + OFF_LR);
  bf16_t* QI = (bf16_t*)(p.ws + OFF_QI); bf16_t* KST = (bf16_t*)(p.ws + OFF_KST); bf16_t* VT = (bf16_t*)(p.ws + OFF_VT);
  float* DD = (float*)(p.ws + OFF_DD); bf16_t* O = (bf16_t*)(p.ws + OFF_O);
  for (int u = bid; u < 2080; u += nb) {
    int b, n, hd; size_t row0; const bool isctx = u >= 2048;
    if (!isctx) { hd = u & 3; n = (u >> 2) & 255; b = u >> 10; row0 = (size_t)b * 16384 + n * 64; }
    else { int v = u - 2048; hd = v & 3; n = (v >> 2) & 3; b = v >> 4; row0 = (size_t)T + b * 256 + n * 64; }
    { const bf16_t* vp = QKV + (row0 + lane) * 2048 + 1024 + hd * 256 + wid * 32;
#pragma unroll
      for (int q = 0; q < 4; ++q) { bf16x8 v = *(const bf16x8*)(vp + q * 8);
#pragma unroll
        for (int e = 0; e < 8; ++e) VTl[(wid * 32 + q * 8 + e) * 72 + lane] = (bf16_t)v[e]; } }
    for (int dir = 0; dir < 2; ++dir) {
      { const float* wg = dir ? p.wg_b : p.wg_f; const float* bg = dir ? p.bg_b : p.bg_f;
        *(f32x4*)(wgL + (tid >> 5) * 128 + (tid & 31) * 4) = *(const f32x4*)(wg + (tid >> 5) * 512 + hd * 128 + (tid & 31) * 4);
        if (tid < 128) wgL[2048 + tid] = bg[hd * 128 + tid]; }
      __syncthreads();
      { const float* lr = LR + (row0 + lane) * 32 + dir * 16;
        f32x4 l0 = *(const f32x4*)(lr), l1 = *(const f32x4*)(lr + 4), l2 = *(const f32x4*)(lr + 8), l3 = *(const f32x4*)(lr + 12);
#pragma unroll 4
        for (int e = 0; e < 16; ++e) { const int dk = wid * 16 + e; float z = wgL[2048 + dk];
#pragma unroll
          for (int r = 0; r < 4; ++r) z += l0[r] * wgL[r * 128 + dk] + l1[r] * wgL[(4 + r) * 128 + dk] + l2[r] * wgL[(8 + r) * 128 + dk] + l3[r] * wgL[(12 + r) * 128 + dk];
          bL[lane * 129 + dk] = (fminf(z, 0.f) - __logf(1.f + __expf(-fabsf(z)))) * (1.f / 16.f); } }
      __syncthreads();
      { const int col = tid & 127, seg = tid >> 7; float a = 0.f;
#pragma unroll
        for (int i = 0; i < 16; ++i) { const int row = dir ? (seg * 16 + 15 - i) : (seg * 16 + i); a += bL[row * 129 + col]; bL[row * 129 + col] = a; }
        tot[seg * 128 + col] = a; }
      __syncthreads();
      { const int col = tid & 127, seg = tid >> 7; float off = 0.f;
#pragma unroll
        for (int s2 = 0; s2 < 4; ++s2) { const bool use = dir ? (s2 > seg) : (s2 < seg); if (use) off += tot[s2 * 128 + col]; }
#pragma unroll
        for (int i = 0; i < 16; ++i) bL[(seg * 16 + i) * 129 + col] += off; }
      __syncthreads();
      { const int j = lane;
        const bf16_t* qp = QKV + (row0 + j) * 2048 + hd * 128 + wid * 16; const bf16_t* kp = qp + 512;
        bf16x8 q0 = *(const bf16x8*)qp, q1 = *(const bf16x8*)(qp + 8), k0 = *(const bf16x8*)kp, k1 = *(const bf16x8*)(kp + 8);
        const int jref = dir ? 32 : 31, jlast = dir ? 0 : 63;
        float qiv[16], qsv[16], ksv[16];
#pragma unroll
        for (int e = 0; e < 16; ++e) { const int dk = wid * 16 + e; float bq = bL[j * 129 + dk], br = bL[jref * 129 + dk], bl = bL[jlast * 129 + dk];
          float qv = bf2f((bf16_t)(e < 8 ? q0[e & 7] : q1[e & 7])), kv = bf2f((bf16_t)(e < 8 ? k0[e & 7] : k1[e & 7]));
          qsv[e] = qv * __expf(bq - br); ksv[e] = kv * __expf(br - bq);
          qiv[e] = qv * __expf(bq); KT[dk * 72 + j] = f2bf(kv * __expf(bl - bq));
          if (j == jlast) DD[((size_t)u * 2 + dir) * 128 + dk] = __expf(bl); }
        u32x4 w0, w1;
        w0.x = pk2(qsv[0], qsv[1]); w0.y = pk2(qsv[2], qsv[3]); w0.z = pk2(qsv[4], qsv[5]); w0.w = pk2(qsv[6], qsv[7]);
        w1.x = pk2(qsv[8], qsv[9]); w1.y = pk2(qsv[10], qsv[11]); w1.z = pk2(qsv[12], qsv[13]); w1.w = pk2(qsv[14], qsv[15]);
        *(u32x4*)(Qs + j * 136 + wid * 16) = w0; *(u32x4*)(Qs + j * 136 + wid * 16 + 8) = w1;
        w0.x = pk2(ksv[0], ksv[1]); w0.y = pk2(ksv[2], ksv[3]); w0.z = pk2(ksv[4], ksv[5]); w0.w = pk2(ksv[6], ksv[7]);
        w1.x = pk2(ksv[8], ksv[9]); w1.y = pk2(ksv[10], ksv[11]); w1.z = pk2(ksv[12], ksv[13]); w1.w = pk2(ksv[14], ksv[15]);
        *(u32x4*)(Ks + j * 136 + wid * 16) = w0; *(u32x4*)(Ks + j * 136 + wid * 16 + 8) = w1;
        w0.x = pk2(qiv[0], qiv[1]); w0.y = pk2(qiv[2], qiv[3]); w0.z = pk2(qiv[8], qiv[9]); w0.w = pk2(qiv[10], qiv[11]);
        w1.x = pk2(qiv[4], qiv[5]); w1.y = pk2(qiv[6], qiv[7]); w1.z = pk2(qiv[12], qiv[13]); w1.w = pk2(qiv[14], qiv[15]);
        bf16_t* qo = QI + (((size_t)u * 2 + dir) * 64 + j) * 128 + wid * 16;
        *(u32x4*)qo = w0; *(u32x4*)(qo + 8) = w1; }
      __syncthreads();
      { const int ti = wid >> 1, tj0 = 2 * (wid & 1);
#pragma unroll
        for (int tt = 0; tt < 2; ++tt) { const int tj = tj0 + tt; f32x4 acc = {0, 0, 0, 0};
#pragma unroll
          for (int s = 0; s < 4; ++s) { bf16x8 a = *(const bf16x8*)(Qs + (16 * ti + fr) * 136 + 32 * s + 8 * fq), bb = *(const bf16x8*)(Ks + (16 * tj + fr) * 136 + 32 * s + 8 * fq);
            acc = MFMA16(bb, a, acc); }
          const int i = 16 * ti + fr;
#pragma unroll
          for (int jj = 0; jj < 4; ++jj) { int jc = 16 * tj + 4 * fq + jj; bool keep = dir ? (jc >= i) : (jc <= i); if (!keep) acc[jj] = 0.f; }
          u32x2 w; w.x = pk2(acc[0], acc[1]); w.y = pk2(acc[2], acc[3]);
          *(u32x2*)(Pm + i * 136 + dir * 64 + 16 * tj + 4 * fq) = w; }
        const int dk = tid >> 2, part = tid & 3;
        bf16_t* ko = KST + (((size_t)u * 2 + dir) * 128 + dk) * 64 + part * 16;
        *(u32x4*)ko = *(const u32x4*)(KT + dk * 72 + part * 16); *(u32x4*)(ko + 8) = *(const u32x4*)(KT + dk * 72 + part * 16 + 8); }
      __syncthreads();
    }
    { const int dv = tid >> 1, part = tid & 1; bf16_t* vo = VT + ((size_t)u * 256 + dv) * 64 + part * 32;
#pragma unroll
      for (int q = 0; q < 4; ++q) *(u32x4*)(vo + q * 8) = *(const u32x4*)(VTl + dv * 72 + part * 32 + q * 8); }
    if (!isctx) {
#pragma unroll
      for (int tt = 0; tt < 2; ++tt) { const int tn = 2 * wid + tt;
        bf16x8 bfv[4];
#pragma unroll
        for (int s = 0; s < 4; ++s) bfv[s] = *(const bf16x8*)(VTl + (16 * tn + fr) * 72 + ((32 * s + 8 * fq) & 63));
#pragma unroll
        for (int ti = 0; ti < 4; ++ti) { f32x4 acc = {0, 0, 0, 0};
#pragma unroll
          for (int s = 0; s < 4; ++s) { bf16x8 a = *(const bf16x8*)(Pm + (16 * ti + fr) * 136 + 32 * s + 8 * fq); acc = MFMA16(bfv[s], a, acc); }
          u32x2 w; w.x = pk2(acc[0], acc[1]); w.y = pk2(acc[2], acc[3]);
          *(u32x2*)(O + (row0 + 16 * ti + fr) * 1024 + hd * 256 + 16 * tn + 4 * fq) = w; } }
    }
    __syncthreads();
  }
}

DI int fpad(int n) { return n + (n >> 4); }
DI int otid() { int t = threadIdx.x; asm volatile("" : "+v"(t)); return t; }
DI f32x2 cmul(f32x2 a, f32x2 b) { return (f32x2){a.x * b.x - a.y * b.y, a.x * b.y + a.y * b.x}; }
DI f32x2 cmulc(f32x2 a, f32x2 b) { return (f32x2){a.x * b.x + a.y * b.y, a.y * b.x - a.x * b.y}; }
DI f32x2 twid(float frac) { return (f32x2){__builtin_amdgcn_cosf(frac), -__builtin_amdgcn_sinf(frac)}; }
template <bool INV> DI void dft4(f32x2& a, f32x2& b, f32x2& c, f32x2& d) {
  f32x2 s0 = a + c, s1 = a - c, s2 = b + d, s3 = b - d;
  f32x2 t = INV ? (f32x2){-s3.y, s3.x} : (f32x2){s3.y, -s3.x};
  a = s0 + s2; c = s0 - s2; b = s1 + t; d = s1 - t;
}
template <bool INV> DI void dft16(f32x2 (&x)[16]) {
  constexpr float CS[10] = {1.f, 0.9238795325112867f, 0.7071067811865476f, 0.3826834323650898f, 0.f, -0.3826834323650898f, -0.7071067811865476f, -0.9238795325112867f, -1.f, -0.9238795325112867f};
  constexpr float SN[10] = {0.f, 0.3826834323650898f, 0.7071067811865476f, 0.9238795325112867f, 1.f, 0.9238795325112867f, 0.7071067811865476f, 0.3826834323650898f, 0.f, -0.3826834323650898f};
#pragma unroll
  for (int a = 0; a < 4; ++a) dft4<INV>(x[a], x[a + 4], x[a + 8], x[a + 12]);
#pragma unroll
  for (int a = 1; a < 4; ++a)
#pragma unroll
    for (int c = 1; c < 4; ++c) { const int m = a * c; f32x2 w = {CS[m], INV ? SN[m] : -SN[m]}; x[a + 4 * c] = cmul(x[a + 4 * c], w); }
#pragma unroll
  for (int c = 0; c < 4; ++c) dft4<INV>(x[4 * c], x[4 * c + 1], x[4 * c + 2], x[4 * c + 3]);
}
#define OIDX(k) (4 * ((k) & 3) + ((k) >> 2))

DI void twpow(f32x2 w1, f32x2 (&w)[16]) {
  w[1] = w1; w[2] = cmul(w1, w1); w[4] = cmul(w[2], w[2]); w[8] = cmul(w[4], w[4]);
  w[3] = cmul(w[2], w[1]); w[5] = cmul(w[4], w[1]); w[6] = cmul(w[4], w[2]); w[7] = cmul(w[4], w[3]);
  w[9] = cmul(w[8], w[1]); w[10] = cmul(w[8], w[2]); w[11] = cmul(w[8], w[3]); w[12] = cmul(w[8], w[4]);
  w[13] = cmul(w[8], w[5]); w[14] = cmul(w[8], w[6]); w[15] = cmul(w[8], w[7]);
}
template <bool INV> DI void pass16(f32x2* X, int id, int ls) {
  const int s = 1 << ls, n0 = id & (s - 1), base = (id >> ls) << (ls + 4);
  f32x2 w[16]; twpow(twid((float)n0 / (float)(16 << ls)), w);
  f32x2 v[16];
#pragma unroll
  for (int k = 0; k < 16; ++k) v[k] = X[fpad(base + k * s + n0)];
  if (INV) {
#pragma unroll
    for (int k = 1; k < 16; ++k) v[k] = cmulc(v[k], w[k]);
    dft16<true>(v);
#pragma unroll
    for (int k = 0; k < 16; ++k) X[fpad(base + k * s + n0)] = v[OIDX(k)];
  } else {
    dft16<false>(v);
#pragma unroll
    for (int k = 0; k < 16; ++k) { f32x2 y = v[OIDX(k)]; if (k) y = cmul(y, w[k]); X[fpad(base + k * s + n0)] = y; }
  }
}
DI void fft_fwd23(f32x2* X) {
  __syncthreads();
  { const int tid = otid();
#pragma unroll
  for (int q = 0; q < 2; ++q) pass16<false>(X, tid + 512 * q, 8); }
  __syncthreads();
  { const int tid = otid();
#pragma unroll
  for (int q = 0; q < 2; ++q) pass16<false>(X, tid + 512 * q, 4); }
  __syncthreads();
}
DI void f1_store(f32x2* X, int n0, f32x2 a, f32x2 b, f32x2 c, f32x2 d) {
  dft4<false>(a, b, c, d);
  f32x2 w1 = twid((float)n0 * (1.f / 16384.f)), w2 = cmul(w1, w1), w3 = cmul(w2, w1);
  X[fpad(n0)] = a; X[fpad(4096 + n0)] = cmul(b, w1); X[fpad(8192 + n0)] = cmul(c, w2); X[fpad(12288 + n0)] = cmul(d, w3);
}

DI void fft_channel(const P& p, int c, f32x2* G1, f32x2* G2, f32x2* G3) {
  f32x2* X = (f32x2*)g_smem;
  const float* hf = (const float*)(p.ws + OFF_HT) + (size_t)c * 16384; const float* hb = hf + (size_t)1024 * 16384;
  float* zc0 = (float*)(p.ws + OFF_ZC) + (size_t)c * 16384; float* zc1 = zc0 + (size_t)1024 * 16384;
  const float skip = p.skip[c];
  const float R2 = 0.7071067811865476f;
#pragma unroll 1
  for (int rnd = 0; rnd < 2; ++rnd) {
#pragma unroll 1
    for (int q0 = 0; q0 < 8; q0 += 4) {
      const int tid = otid();
      float f[4][4], g[4][4];
#pragma unroll
      for (int qq = 0; qq < 4; ++qq)
#pragma unroll
        for (int jx = 0; jx < 4; ++jx) { const int n = tid + 512 * (q0 + qq) + 4096 * jx; f[qq][jx] = hf[n]; g[qq][jx] = n ? hb[16384 - n] : 0.f; }
#pragma unroll
      for (int qq = 0; qq < 4; ++qq) { const int n0 = tid + 512 * (q0 + qq); f32x2 v[4];
        if (rnd == 0) {
#pragma unroll
          for (int jx = 0; jx < 4; ++jx) v[jx] = (f32x2){f[qq][jx] + g[qq][jx], 0.f};
        } else { const f32x2 w0 = twid((float)n0 * (1.f / 32768.f));
          const f32x2 w1 = cmul(w0, (f32x2){R2, -R2}), w2 = (f32x2){w0.y, -w0.x}, w3 = cmul(w0, (f32x2){-R2, -R2});
          v[0] = w0 * (f[qq][0] - g[qq][0]); v[1] = w1 * (f[qq][1] - g[qq][1]); v[2] = w2 * (f[qq][2] - g[qq][2]); v[3] = w3 * (f[qq][3] - g[qq][3]); }
        f1_store(X, n0, v[0], v[1], v[2], v[3]); }
    }
    fft_fwd23(X);
    f32x2* Gk = rnd ? G2 : G1;
#pragma unroll 1
    for (int q = 0; q < 2; ++q) { const int id = otid() + 512 * q; f32x2 v[16];
#pragma unroll
      for (int k = 0; k < 16; ++k) v[k] = X[fpad(id * 16 + k)];
      dft16<false>(v);
#pragma unroll
      for (int k = 0; k < 16; k += 2) { f32x2 a = v[OIDX(k)] * (1.f / 32768.f), b = v[OIDX(k + 1)] * (1.f / 32768.f); *(f32x4*)(Gk + id * 16 + k) = (f32x4){a.x, a.y, b.x, b.y}; } }
    __syncthreads();
  }
#pragma unroll 1
  for (int rnd = 0; rnd < 2; ++rnd) {
#pragma unroll 1
    for (int q0 = 0; q0 < 8; q0 += 4) {
      const int tid = otid();
      f32x2 z[4][4];
#pragma unroll
      for (int qq = 0; qq < 4; ++qq)
#pragma unroll
        for (int jx = 0; jx < 4; ++jx) { const int n = tid + 512 * (q0 + qq) + 4096 * jx; z[qq][jx] = (f32x2){zc0[n], zc1[n]}; }
#pragma unroll
      for (int qq = 0; qq < 4; ++qq) { const int n0 = tid + 512 * (q0 + qq);
        if (rnd) { const f32x2 w0 = twid((float)n0 * (1.f / 32768.f));
          const f32x2 w1 = cmul(w0, (f32x2){R2, -R2}), w2 = (f32x2){w0.y, -w0.x}, w3 = cmul(w0, (f32x2){-R2, -R2});
          z[qq][0] = cmul(z[qq][0], w0); z[qq][1] = cmul(z[qq][1], w1); z[qq][2] = cmul(z[qq][2], w2); z[qq][3] = cmul(z[qq][3], w3); }
        f1_store(X, n0, z[qq][0], z[qq][1], z[qq][2], z[qq][3]); }
    }
    fft_fwd23(X);
    const f32x2* Gk = rnd ? G2 : G1;
#pragma unroll 1
    for (int q = 0; q < 2; ++q) { const int id = otid() + 512 * q; f32x2 v[16], w[16];
      f32x4 kk[8];
#pragma unroll
      for (int k = 0; k < 8; ++k) kk[k] = *(const f32x4*)(Gk + id * 16 + 2 * k);
#pragma unroll
      for (int k = 0; k < 16; ++k) v[k] = X[fpad(id * 16 + k)];
      dft16<false>(v);
#pragma unroll
      for (int k = 0; k < 16; k += 2) { w[k] = cmul(v[OIDX(k)], (f32x2){kk[k >> 1].x, kk[k >> 1].y}); w[k + 1] = cmul(v[OIDX(k + 1)], (f32x2){kk[k >> 1].z, kk[k >> 1].w}); }
      dft16<true>(w);
#pragma unroll
      for (int k = 0; k < 16; ++k) X[fpad(id * 16 + k)] = w[OIDX(k)]; }
    __syncthreads();
    { const int tid = otid();
#pragma unroll
    for (int q = 0; q < 2; ++q) pass16<true>(X, tid + 512 * q, 4); }
    __syncthreads();
    { const int tid = otid();
#pragma unroll
    for (int q = 0; q < 2; ++q) pass16<true>(X, tid + 512 * q, 8); }
    __syncthreads();
#pragma unroll 1
    for (int q0 = 0; q0 < 8; q0 += 4) {
      const int tid = otid();
      f32x2 r1[4][4], zz[4][4];
      if (rnd) {
#pragma unroll
        for (int qq = 0; qq < 4; ++qq)
#pragma unroll
          for (int jx = 0; jx < 4; ++jx) { const int n = tid + 512 * (q0 + qq) + 4096 * jx; r1[qq][jx] = G3[n]; zz[qq][jx] = (f32x2){zc0[n], zc1[n]}; }
      }
#pragma unroll
      for (int qq = 0; qq < 4; ++qq) { const int n0 = tid + 512 * (q0 + qq);
        const f32x2 t1 = twid((float)n0 * (1.f / 16384.f)), t2 = cmul(t1, t1), t3 = cmul(t2, t1);
        f32x2 v[4];
        v[0] = X[fpad(n0)]; v[1] = cmulc(X[fpad(4096 + n0)], t1); v[2] = cmulc(X[fpad(8192 + n0)], t2); v[3] = cmulc(X[fpad(12288 + n0)], t3);
        dft4<true>(v[0], v[1], v[2], v[3]);
        if (rnd == 0) {
#pragma unroll
          for (int jx = 0; jx < 4; ++jx) G3[n0 + 4096 * jx] = v[jx];
        } else { const f32x2 w0 = twid((float)n0 * (1.f / 32768.f));
          const f32x2 wj[4] = {w0, cmul(w0, (f32x2){R2, -R2}), (f32x2){w0.y, -w0.x}, cmul(w0, (f32x2){-R2, -R2})};
#pragma unroll
          for (int jx = 0; jx < 4; ++jx) { f32x2 y = r1[qq][jx] + cmulc(v[jx], wj[jx]) + zz[qq][jx] * skip; zc0[n0 + 4096 * jx] = y.x; zc1[n0 + 4096 * jx] = y.y; } } }
    }
    __syncthreads();
  }
}

DI bf16x8 pack8(const f32x16& x, int s) {
  u32x4 r; r.x = pk2(x[8 * s], x[8 * s + 1]); r.y = pk2(x[8 * s + 2], x[8 * s + 3]); r.z = pk2(x[8 * s + 4], x[8 * s + 5]); r.w = pk2(x[8 * s + 6], x[8 * s + 7]);
  return __builtin_bit_cast(bf16x8, r);
}
constexpr int SEGLEN = 17, NSEG = 16;
DI void scan_step_addr(const P& p, int b, int hd, int dir, int step, bool& isctx, int& n, size_t& unit) {
  isctx = step < 4;
  if (isctx) { n = dir ? 3 - step : step; unit = 2048 + (size_t)(b * 4 + n) * 4 + hd; }
  else { int m = step - 4; n = dir ? 255 - m : m; unit = (size_t)(b * 256 + n) * 4 + hd; }
}
DI void scan_decay(f32x16 (&S)[4], float d0, float d1, int h2) {
#pragma unroll
  for (int a = 0; a < 4; ++a)
#pragma unroll
    for (int i = 0; i < 16; ++i) { const int src = 32 * (a & 1) + (i & 3) + 8 * (i >> 2) + 4 * h2; S[a][i] *= __shfl((a < 2) ? d0 : d1, src, 64); }
}
template <int V> struct IC { static constexpr int value = V; };
template <bool OUT>
DI void scan_segment(const P& p, f32x16 (&S)[4], int b, int hd, int dir, int s0, int s1, float& dp0, float& dp1) {
  const int tid = threadIdx.x, wid = tid >> 6, lane = tid & 63, r = lane & 31, h2 = lane >> 5;
  const bf16_t* QI = (const bf16_t*)(p.ws + OFF_QI); const bf16_t* KST = (const bf16_t*)(p.ws + OFF_KST); const bf16_t* VT = (const bf16_t*)(p.ws + OFF_VT);
  const float* DD = (const float*)(p.ws + OFF_DD); bf16_t* OFB = (bf16_t*)(p.ws + OFF_OFB);
  char* img = g_smem;
  bf16x8 kq[2][2], kk[2][2], vb[2][4]; float d0[2], d1[2];
  auto fetch = [&](int step, auto PP, bool with_v) {
    constexpr int Q = decltype(PP)::value;
    bool isctx; int n; size_t unit; scan_step_addr(p, b, hd, dir, step, isctx, n, unit);
    const bf16_t* qi = QI + (unit * 2 + dir) * 8192; const bf16_t* kst = KST + (unit * 2 + dir) * 8192; const float* dd = DD + (unit * 2 + dir) * 128;
    const bf16_t* vt = VT + unit * 16384 + (size_t)(wid * 32) * 64;
#pragma unroll
    for (int e = 0; e < 2; ++e) { const int f = 2 * wid + e;
      if (OUT) { const int m = f >> 3, a = (f >> 1) & 3, s = f & 1; kq[Q][e] = *(const bf16x8*)(qi + (32 * m + r) * 128 + a * 32 + s * 16 + h2 * 8); }
      { const int s = f >> 2, a = f & 3; kk[Q][e] = *(const bf16x8*)(kst + (32 * a + r) * 64 + s * 16 + h2 * 8); } }
    if (with_v) {
#pragma unroll
      for (int s = 0; s < 4; ++s) vb[Q][s] = *(const bf16x8*)(vt + r * 64 + s * 16 + h2 * 8); }
    d0[Q] = dd[lane]; d1[Q] = dd[64 + lane];
  };
  auto fetch_v = [&](int step, auto PP) {
    constexpr int Q = decltype(PP)::value;
    bool isctx; int n; size_t unit; scan_step_addr(p, b, hd, dir, step, isctx, n, unit);
    const bf16_t* vt = VT + unit * 16384 + (size_t)(wid * 32) * 64;
#pragma unroll
    for (int s = 0; s < 4; ++s) vb[Q][s] = *(const bf16x8*)(vt + r * 64 + s * 16 + h2 * 8);
  };
  auto body = [&](int step, auto PP) {
    constexpr int Q = decltype(PP)::value;
    char* ib = img + Q * 32768;
#pragma unroll
    for (int e = 0; e < 2; ++e) { const int f = 2 * wid + e;
      if (OUT) *(bf16x8*)(ib + f * 1024 + lane * 16) = kq[Q][e];
      *(bf16x8*)(ib + (16 + f) * 1024 + lane * 16) = kk[Q][e]; }
    const float c0 = d0[Q], c1 = d1[Q];
    bool isctx; int n; size_t unit; scan_step_addr(p, b, hd, dir, step, isctx, n, unit);
    __syncthreads();
    fetch(min(step + 2, s1 - 1), PP, false);
    if (OUT && !isctx) {
      f32x16 o0, o1;
#pragma unroll
      for (int i = 0; i < 16; ++i) { o0[i] = 0.f; o1[i] = 0.f; }
#pragma unroll
      for (int a = 0; a < 4; ++a)
#pragma unroll
        for (int s = 0; s < 2; ++s) { bf16x8 sb = pack8(S[a], s);
          bf16x8 q0 = *(const bf16x8*)(ib + (a * 2 + s) * 1024 + lane * 16), q1 = *(const bf16x8*)(ib + (8 + a * 2 + s) * 1024 + lane * 16);
          o0 = MFMA32(q0, sb, o0); o1 = MFMA32(q1, sb, o1); }
      const int tl = otid(), ro = tl & 31, ho = (tl >> 5) & 1;
      bf16_t* ob = OFB + (size_t)dir * T * 1024 + ((size_t)b * 16384 + (size_t)n * 64 + 4 * ho) * 1024 + hd * 256 + wid * 32 + ro;
#pragma unroll
      for (int i = 0; i < 16; ++i) { const int row = (i & 3) + 8 * (i >> 2); ob[(size_t)row * 1024] = f2bf(o0[i]); ob[(size_t)(32 + row) * 1024] = f2bf(o1[i]); }
    }
    if (!OUT || step + 1 < s1) {
      scan_decay(S, c0, c1, h2);
      if (!OUT && wid == 0) { dp0 *= c0; dp1 *= c1; }
#pragma unroll
      for (int s = 0; s < 4; ++s)
#pragma unroll
        for (int a = 0; a < 4; ++a) { bf16x8 ka = *(const bf16x8*)(ib + (16 + s * 4 + a) * 1024 + lane * 16); S[a] = MFMA32(ka, vb[Q][s], S[a]); }
    }
    fetch_v(min(step + 2, s1 - 1), PP);
  };
  fetch(s0, IC<0>{}, true); fetch(min(s0 + 1, s1 - 1), IC<1>{}, true);
#pragma unroll 1
  for (int step = s0; step < s1; step += 2) {
    body(step, IC<0>{});
    if (step + 1 < s1) body(step + 1, IC<1>{});
  }
  __syncthreads();
}
DI void gla_scan_A(const P& p, int u) {
  const int tid = threadIdx.x, wid = tid >> 6, lane = tid & 63;
  const int chain = u >> 4, g = u & 15; if (g == NSEG - 1) return;
  const int b = chain >> 3, hd = (chain >> 1) & 3, dir = chain & 1;
  float* SLOC = (float*)(p.ws + OFF_SLOC); float* DSEG = (float*)(p.ws + OFF_DSEG);
  f32x16 S[4];
#pragma unroll
  for (int a = 0; a < 4; ++a)
#pragma unroll
    for (int i = 0; i < 16; ++i) S[a][i] = 0.f;
  float dp0 = 1.f, dp1 = 1.f;
  const int s0 = g * SEGLEN, s1 = min(s0 + SEGLEN, 260);
  scan_segment<false>(p, S, b, hd, dir, s0, s1, dp0, dp1);
  float* so = SLOC + ((size_t)u * 8 + wid) * 4096 + lane;
#pragma unroll
  for (int a = 0; a < 4; ++a)
#pragma unroll
    for (int i = 0; i < 16; ++i) so[(a * 16 + i) * 64] = S[a][i];
  if (wid == 0) { DSEG[(size_t)u * 128 + lane] = dp0; DSEG[(size_t)u * 128 + 64 + lane] = dp1; }
}
DI void gla_scan_C(const P& p, int u) {
  const int tid = threadIdx.x, wid = tid >> 6, lane = tid & 63, h2 = lane >> 5;
  const int chain = u >> 4, g = u & 15;
  const int b = chain >> 3, hd = (chain >> 1) & 3, dir = chain & 1;
  const float* SLOC = (const float*)(p.ws + OFF_SLOC); const float* DSEG = (const float*)(p.ws + OFF_DSEG);
  f32x16 S[4];
#pragma unroll
  for (int a = 0; a < 4; ++a)
#pragma unroll
    for (int i = 0; i < 16; ++i) S[a][i] = 0.f;
#pragma unroll 1
  for (int gp = 0; gp < g; ++gp) {
    const float* si = SLOC + ((size_t)(chain * 16 + gp) * 8 + wid) * 4096 + lane; const float* dg = DSEG + (size_t)(chain * 16 + gp) * 128;
    const float g0 = dg[lane], g1 = dg[64 + lane];
    float sv[32];
#pragma unroll
    for (int e = 0; e < 32; ++e) sv[e] = si[e * 64];
    scan_decay(S, g0, g1, h2);
#pragma unroll
    for (int hh = 0; hh < 2; ++hh) {
      if (hh) {
#pragma unroll
        for (int e = 0; e < 32; ++e) sv[e] = si[(32 + e) * 64]; }
#pragma unroll
      for (int e = 0; e < 32; ++e) S[hh * 2 + (e >> 4)][e & 15] += sv[e]; }
  }
  float dpa = 1.f, dpb = 1.f;
  const int s0 = g * SEGLEN, s1 = min(s0 + SEGLEN, 260);
  scan_segment<true>(p, S, b, hd, dir, s0, s1, dpa, dpb);
}

DI void phase_global_a(const P& p, int bid, int nb) {
  for (int u = bid; u < 256; u += nb) gla_scan_A(p, u);
  f32x2* G = (f32x2*)(p.ws + OFF_FFTS) + (size_t)bid * 3 * 16384;
  for (int c = bid; c < 1024; c += nb) fft_channel(p, c, G, G + 16384, G + 32768);
}
DI void phase_global_b(const P& p, int bid, int nb) {
  for (int u = bid; u < 256; u += nb) gla_scan_C(p, u);
  const int tid = threadIdx.x; (void)tid;
  bf16_t* W2 = (bf16_t*)(p.ws + OFF_W2);
#pragma unroll 1
  for (int job = 0; job < 6; ++job) {
    const float* src; int ld, K, ncols, dstld, drow0, mode; bf16_t* dst;
    switch (job) {
      case 0: src = p.p_gla; ld = 2048; K = 1024; ncols = 2048; dst = W2 + W2_PM / 2; dstld = 2048; drow0 = 0; mode = 0; break;
      case 1: src = p.p_hy; ld = 2048; K = 1024; ncols = 2048; dst = W2 + W2_PM / 2 + 1024; dstld = 2048; drow0 = 0; mode = 0; break;
      case 2: src = p.w_out; ld = 2048; K = 2048; ncols = 2048; dst = W2 + W2_WOUT / 2; dstld = 2048; drow0 = 0; mode = 0; break;
      case 3: src = p.ffn_gate; ld = 5632; K = 2048; ncols = 5632; dst = W2 + W2_WGU / 2; dstld = 2048; drow0 = 0; mode = 1; break;
      case 4: src = p.ffn_up; ld = 5632; K = 2048; ncols = 5632; dst = W2 + W2_WGU / 2; dstld = 2048; drow0 = 128; mode = 1; break;
      default: src = p.ffn_down; ld = 2048; K = 5632; ncols = 2048; dst = W2 + W2_WD / 2; dstld = 5632; drow0 = 0; mode = 0; break; }
    wconv(src, ld, K, 0, ncols, dst, dstld, drow0, mode, bid, nb);
  }
}

DI void phase_mergeprep(const P& p, int bid, int nb) {
  const int tid = threadIdx.x, wid = tid >> 6, lane = tid & 63;
  bf16_t* AM = (bf16_t*)(p.ws + OFF_AM);
  {
    const bf16_t* O = (const bf16_t*)(p.ws + OFF_O); const bf16_t* G = (const bf16_t*)(p.ws + OFF_G);
    for (int row = bid * 8 + wid; row < T; row += nb * 8) {
      const int c0 = lane * 16; const bf16_t* op = O + (size_t)row * 1024 + c0;
      f32x4 v[4]; float ss = 0.f;
      const bf16_t* ofp = (const bf16_t*)(p.ws + OFF_OFB) + (size_t)row * 1024 + c0; const bf16_t* obp = ofp + (size_t)T * 1024;
      u32x4 f0 = *(const u32x4*)ofp, f1 = *(const u32x4*)(ofp + 8), b0 = *(const u32x4*)obp, b1 = *(const u32x4*)(obp + 8);
      const u32x4 i0 = *(const u32x4*)op, i1 = *(const u32x4*)(op + 8);
#pragma unroll
      for (int q = 0; q < 4; ++q) { const unsigned ia = q < 2 ? i0[2 * (q & 1)] : i1[2 * (q & 1)], ib = q < 2 ? i0[2 * (q & 1) + 1] : i1[2 * (q & 1) + 1];
        v[q] = (f32x4){bflo(ia), bfhi(ia), bflo(ib), bfhi(ib)};
        const unsigned fa = q < 2 ? f0[2 * (q & 1)] : f1[2 * (q & 1)], fb = q < 2 ? f0[2 * (q & 1) + 1] : f1[2 * (q & 1) + 1];
        const unsigned ba = q < 2 ? b0[2 * (q & 1)] : b1[2 * (q & 1)], bb = q < 2 ? b0[2 * (q & 1) + 1] : b1[2 * (q & 1) + 1];
        v[q].x += bflo(fa) + bflo(ba); v[q].y += bfhi(fa) + bfhi(ba); v[q].z += bflo(fb) + bflo(bb); v[q].w += bfhi(fb) + bfhi(bb);
        ss += v[q].x * v[q].x + v[q].y * v[q].y + v[q].z * v[q].z + v[q].w * v[q].w; }
      ss += __shfl_xor(ss, 1, 64); ss += __shfl_xor(ss, 2, 64); ss += __shfl_xor(ss, 4, 64); ss += __shfl_xor(ss, 8, 64);
      const float rstd = rsqrtf(ss * (1.f / 256.f) + 1e-6f);
      const bf16_t* gp = G + (size_t)row * 1024 + c0; u32x4 g0 = *(const u32x4*)gp, g1 = *(const u32x4*)(gp + 8);
      const float* nw = p.gla_norm + (c0 & 255);
      float gv[16];
#pragma unroll
      for (int e = 0; e < 4; ++e) { gv[2 * e] = bflo(g0[e]); gv[2 * e + 1] = bfhi(g0[e]); gv[8 + 2 * e] = bflo(g1[e]); gv[8 + 2 * e + 1] = bfhi(g1[e]); }
      float y[16];
#pragma unroll
      for (int e = 0; e < 16; ++e) y[e] = v[e >> 2][e & 3] * rstd * nw[e] * gv[e];
      u32x4 w0, w1;
      w0.x = pk2(y[0], y[1]); w0.y = pk2(y[2], y[3]); w0.z = pk2(y[4], y[5]); w0.w = pk2(y[6], y[7]);
      w1.x = pk2(y[8], y[9]); w1.y = pk2(y[10], y[11]); w1.z = pk2(y[12], y[13]); w1.w = pk2(y[14], y[15]);
      bf16_t* ap = AM + (size_t)row * 2048 + c0; *(u32x4*)ap = w0; *(u32x4*)(ap + 8) = w1;
    }
  }
  {
    f32x2* tile = (f32x2*)g_smem;
    const bf16_t* ZH = (const bf16_t*)(p.ws + OFF_ZH); const float* ZC = (const float*)(p.ws + OFF_ZC);
    for (int it = bid; it < 4096; it += nb) {
      const int tr = it >> 4, ct = it & 15; const int t0 = tr * 64, c0 = ct * 64;
      { const int c = tid >> 3, t8 = (tid & 7) * 8; const float* s0 = ZC + (size_t)(c0 + c) * 16384 + t0 + t8; const float* s1 = s0 + (size_t)1024 * 16384;
        const f32x4 a0 = *(const f32x4*)s0, a1 = *(const f32x4*)(s0 + 4), b0 = *(const f32x4*)s1, b1 = *(const f32x4*)(s1 + 4);
#pragma unroll
        for (int e = 0; e < 4; ++e) { tile[c * 65 + t8 + e] = (f32x2){a0[e], b0[e]}; tile[c * 65 + t8 + 4 + e] = (f32x2){a1[e], b1[e]}; } }
      __syncthreads();
      const int t = tid >> 3, cg8 = (tid & 7) * 8;
#pragma unroll
      for (int b = 0; b < 2; ++b) {
        float x0[8];
#pragma unroll
        for (int e = 0; e < 8; ++e) x0[e] = p.short_b[c0 + cg8 + e];
#pragma unroll
        for (int tap = 0; tap < 3; ++tap) { const int tt = t + tap - 1; if (tt < 0 || tt > 63) continue;
          u32x4 a = *(const u32x4*)(ZH + ((size_t)b * 16384 + t0 + tt) * 1024 + c0 + cg8);
          const float* w0 = p.short_w + tap * 3072 + c0 + cg8;
#pragma unroll
          for (int e = 0; e < 4; ++e) { x0[2 * e] += bflo(a[e]) * w0[2 * e]; x0[2 * e + 1] += bfhi(a[e]) * w0[2 * e + 1]; } }
        float y[8];
#pragma unroll
        for (int e = 0; e < 8; ++e) { f32x2 yy = tile[(cg8 + e) * 65 + t]; y[e] = (b ? yy.y : yy.x) * x0[e]; }
        u32x4 w; w.x = pk2(y[0], y[1]); w.y = pk2(y[2], y[3]); w.z = pk2(y[4], y[5]); w.w = pk2(y[6], y[7]);
        *(u32x4*)(AM + ((size_t)b * 16384 + t0 + t) * 2048 + 1024 + c0 + cg8) = w;
      }
      __syncthreads();
    }
  }
}

struct MergeSched { const bf16_t* A; const bf16_t* Bt; int bid, nb;
  DI bool next(int i, Unit& u) const { const int L = (i >> 1) * nb + bid; const int part = i & 1; if (L >= 1024) return false; unit_order(L, 128, 8, u.pm, u.pn);
    u.a = (const char*)(A + (size_t)u.pm * 256 * 2048 + part * 1024); u.b = (const char*)(Bt + (size_t)u.pn * 256 * 2048 + part * 1024); u.tag = part; return true; } };
DI void phase_merge(const P& p, int bid, int nb) {
  const bf16_t* AM = (const bf16_t*)(p.ws + OFF_AM); const bf16_t* PM = (const bf16_t*)(p.ws + OFF_W2 + W2_PM);
  const bf16_t* MG = (const bf16_t*)p.out; bf16_t* MERGED = (bf16_t*)(p.ws + OFF_MERGED);
  MergeSched S{AM, PM, bid, nb};
  auto E = [&](f32x4 (&acc)[2][2][4][2], const Unit& u, int wr, int wc, int fr, int fq) {
    const int brow = u.pm * 256, bcol = u.pn * 256;
    if (u.tag == 0) {
#pragma unroll
      for (int ai = 0; ai < 2; ++ai)
#pragma unroll
        for (int m = 0; m < 4; ++m) { const bf16_t* rp = MG + (size_t)(brow + ai * 128 + wr * 64 + m * 16 + fr) * 4096 + bcol + wc * 32 + 8 * fq;
#pragma unroll
          for (int bj = 0; bj < 2; ++bj) { u32x4 ga = *(const u32x4*)(rp + bj * 128), gb = *(const u32x4*)(rp + 2048 + bj * 128);
#pragma unroll
            for (int e = 0; e < 4; ++e) { float r0 = (1.f + __expf(-bflo(gb[e]))) / (1.f + __expf(-bflo(ga[e]))), r1 = (1.f + __expf(-bfhi(gb[e]))) / (1.f + __expf(-bfhi(ga[e])));
              acc[ai][bj][m][e >> 1][(e & 1) * 2] *= r0; acc[ai][bj][m][e >> 1][(e & 1) * 2 + 1] *= r1; } } }
    } else {
#pragma unroll
      for (int ai = 0; ai < 2; ++ai)
#pragma unroll
        for (int m = 0; m < 4; ++m) { const size_t rowi = (size_t)(brow + ai * 128 + wr * 64 + m * 16 + fr); const bf16_t* rp = MG + rowi * 4096 + 2048 + bcol + wc * 32 + 8 * fq;
#pragma unroll
          for (int bj = 0; bj < 2; ++bj) { u32x4 gb = *(const u32x4*)(rp + bj * 128); float o[8];
#pragma unroll
            for (int e = 0; e < 4; ++e) { o[2 * e] = acc[ai][bj][m][e >> 1][(e & 1) * 2] * sigmoidf_(bflo(gb[e])); o[2 * e + 1] = acc[ai][bj][m][e >> 1][(e & 1) * 2 + 1] * sigmoidf_(bfhi(gb[e])); }
            u32x4 w; w.x = pk2(o[0], o[1]); w.y = pk2(o[2], o[3]); w.z = pk2(o[4], o[5]); w.w = pk2(o[6], o[7]);
            *(u32x4*)(MERGED + rowi * 2048 + bcol + bj * 128 + wc * 32 + 8 * fq) = w; } }
    }
  };
  gemm_stream(2048, 2048, 1024, S, E);
}

DI void phase_wout(const P& p, int bid, int nb) {
  const bf16_t* MERGED = (const bf16_t*)(p.ws + OFF_MERGED); const bf16_t* WO = (const bf16_t*)(p.ws + OFF_W2 + W2_WOUT); bf16_t* MIX = (bf16_t*)(p.ws + OFF_MIX);
  GridSched S{MERGED, WO, 2048, 2048, 128, 8, bid, nb};
  auto E = [&](f32x4 (&acc)[2][2][4][2], const Unit& u, int wr, int wc, int fr, int fq) { store_tile_bf16<0>(acc, MIX, 2048, u.pm * 256, u.pn * 256, 1.f, wr, wc, fr, fq); };
  gemm_stream(2048, 2048, 2048, S, E);
}

DI void phase_rowmid(const P& p, int bid, int nb) {
  const int tid = threadIdx.x, wid = tid >> 6, lane = tid & 63;
  const float* MOD = (const float*)(p.ws + OFF_MOD); const bf16_t* MIX = (const bf16_t*)(p.ws + OFF_MIX); bf16_t* HX2 = (bf16_t*)(p.ws + OFF_HX2); bf16_t* X1B = (bf16_t*)(p.ws + OFF_MIX);
  for (int row = bid * 8 + wid; row < T; row += nb * 8) {
    const float* md = MOD + (row >> 14) * 12288;
    float mv[32]; float ss = 0.f;
#pragma unroll
    for (int q = 0; q < 4; ++q) { u32x4 a = *(const u32x4*)(MIX + (size_t)row * 2048 + q * 512 + lane * 8);
#pragma unroll
      for (int e = 0; e < 4; ++e) { mv[q * 8 + 2 * e] = bflo(a[e]); mv[q * 8 + 2 * e + 1] = bfhi(a[e]); } }
#pragma unroll
    for (int e = 0; e < 32; ++e) ss += mv[e] * mv[e];
    ss = wave_sum(ss); const float rstd = rsqrtf(ss * (1.f / 2048.f) + 1e-6f);
    float ss2 = 0.f;
#pragma unroll
    for (int q = 0; q < 4; ++q)
#pragma unroll
      for (int hh = 0; hh < 2; ++hh) { const int idx = q * 512 + lane * 8 + hh * 4;
        f32x4 xv = *(const f32x4*)(p.x + (size_t)row * 2048 + idx), w = *(const f32x4*)(p.n_post_mix + idx), g1 = *(const f32x4*)(md + 4096 + idx);
#pragma unroll
        for (int e = 0; e < 4; ++e) { float x1 = xv[e] + g1[e] * (mv[q * 8 + hh * 4 + e] * rstd * w[e]); mv[q * 8 + hh * 4 + e] = x1; ss2 += x1 * x1; } }
    ss2 = wave_sum(ss2); const float rstd2 = rsqrtf(ss2 * (1.f / 2048.f) + 1e-6f);
#pragma unroll
    for (int q = 0; q < 4; ++q) { const int idx = q * 512 + lane * 8; float y[8];
#pragma unroll
      for (int hh = 0; hh < 2; ++hh) { f32x4 w = *(const f32x4*)(p.n_pre_ffn + idx + hh * 4), s2 = *(const f32x4*)(md + 8192 + idx + hh * 4), h2 = *(const f32x4*)(md + 6144 + idx + hh * 4);
#pragma unroll
        for (int e = 0; e < 4; ++e) y[hh * 4 + e] = mv[q * 8 + hh * 4 + e] * rstd2 * w[e] * (1.f + s2[e]) + h2[e]; }
      u32x4 o; o.x = pk2(y[0], y[1]); o.y = pk2(y[2], y[3]); o.z = pk2(y[4], y[5]); o.w = pk2(y[6], y[7]);
      *(u32x4*)(HX2 + (size_t)row * 2048 + idx) = o;
      u32x4 xo; xo.x = pk2(mv[q * 8], mv[q * 8 + 1]); xo.y = pk2(mv[q * 8 + 2], mv[q * 8 + 3]); xo.z = pk2(mv[q * 8 + 4], mv[q * 8 + 5]); xo.w = pk2(mv[q * 8 + 6], mv[q * 8 + 7]);
      *(u32x4*)(X1B + (size_t)row * 2048 + idx) = xo; }
  }
}

DI void phase_ffn1(const P& p, int bid, int nb) {
  const bf16_t* HX2 = (const bf16_t*)(p.ws + OFF_HX2); const bf16_t* WGU = (const bf16_t*)(p.ws + OFF_W2 + W2_WGU); bf16_t* HID = (bf16_t*)(p.ws + OFF_HID);
  GridSched S{HX2, WGU, 2048, 2048, 128, 44, bid, nb};
  auto E = [&](f32x4 (&acc)[2][2][4][2], const Unit& u, int wr, int wc, int fr, int fq) {
#pragma unroll
    for (int ai = 0; ai < 2; ++ai)
#pragma unroll
      for (int m = 0; m < 4; ++m) { float o[8];
#pragma unroll
        for (int n = 0; n < 2; ++n)
#pragma unroll
          for (int jx = 0; jx < 4; ++jx) { float gte = acc[ai][0][m][n][jx], up = acc[ai][1][m][n][jx]; o[n * 4 + jx] = gte * sigmoidf_(gte) * up; }
        u32x4 w; w.x = pk2(o[0], o[1]); w.y = pk2(o[2], o[3]); w.z = pk2(o[4], o[5]); w.w = pk2(o[6], o[7]);
        *(u32x4*)(HID + (size_t)(u.pm * 256 + ai * 128 + wr * 64 + m * 16 + fr) * 5632 + u.pn * 128 + wc * 32 + 8 * fq) = w; }
  };
  gemm_stream(2048, 2048, 2048, S, E);
}
DI void phase_ffn2(const P& p, int bid, int nb) {
  const bf16_t* HID = (const bf16_t*)(p.ws + OFF_HID); const bf16_t* WD = (const bf16_t*)(p.ws + OFF_W2 + W2_WD); bf16_t* FFN = (bf16_t*)(p.ws + OFF_FFN);
  GridSched S{HID, WD, 5632, 5632, 128, 8, bid, nb};
  auto E = [&](f32x4 (&acc)[2][2][4][2], const Unit& u, int wr, int wc, int fr, int fq) { store_tile_bf16<0>(acc, FFN, 2048, u.pm * 256, u.pn * 256, 1.f, wr, wc, fr, fq); };
  gemm_stream(5632, 5632, 5632, S, E);
}
DI void phase_final(const P& p, int bid, int nb) {
  const int tid = threadIdx.x, wid = tid >> 6, lane = tid & 63;
  const float* MOD = (const float*)(p.ws + OFF_MOD); const bf16_t* FFN = (const bf16_t*)(p.ws + OFF_FFN); const bf16_t* X1B = (const bf16_t*)(p.ws + OFF_MIX);
  for (int row = bid * 8 + wid; row < T; row += nb * 8) {
    const float* md = MOD + (row >> 14) * 12288;
    float mv[32]; float ss = 0.f;
#pragma unroll
    for (int q = 0; q < 4; ++q) { u32x4 a = *(const u32x4*)(FFN + (size_t)row * 2048 + q * 512 + lane * 8);
#pragma unroll
      for (int e = 0; e < 4; ++e) { mv[q * 8 + 2 * e] = bflo(a[e]); mv[q * 8 + 2 * e + 1] = bfhi(a[e]); } }
#pragma unroll
    for (int e = 0; e < 32; ++e) ss += mv[e] * mv[e];
    ss = wave_sum(ss); const float rstd = rsqrtf(ss * (1.f / 2048.f) + 1e-6f);
#pragma unroll
    for (int q = 0; q < 4; ++q)
#pragma unroll
      for (int hh = 0; hh < 2; ++hh) { const int idx = q * 512 + lane * 8 + hh * 4;
        const u32x2 xb = *(const u32x2*)(X1B + (size_t)row * 2048 + idx);
        f32x4 xv = {bflo(xb.x), bfhi(xb.x), bflo(xb.y), bfhi(xb.y)}, w = *(const f32x4*)(p.n_post_ffn + idx), g2 = *(const f32x4*)(md + 10240 + idx);
#pragma unroll
        for (int e = 0; e < 4; ++e) xv[e] += g2[e] * (mv[q * 8 + hh * 4 + e] * rstd * w[e]);
        *(f32x4*)(p.out + (size_t)row * 2048 + idx) = xv; }
  }
}

constexpr int NPHASE = 13;
#define RUN_PH(k, call) do { if (ph_lo <= (k) && (k) < ph_hi) { if ((k) > ph_lo) grid.sync(); call; } } while (0)
__global__ void __launch_bounds__(NTHREADS) hybrid_layer_kernel(P p, int ph_lo, int ph_hi) {
  cg::grid_group grid = cg::this_grid();
  const int bid = blockIdx.x, nb = gridDim.x;
  RUN_PH(0, phase_prep(p, bid, nb));
  RUN_PH(1, phase_pre(p, bid, nb));
  RUN_PH(2, phase_gemm1(p, bid, nb));
  RUN_PH(3, phase_local(p, bid, nb));
  RUN_PH(4, phase_global_a(p, bid, nb));
  RUN_PH(5, phase_global_b(p, bid, nb));
  RUN_PH(6, phase_mergeprep(p, bid, nb));
  RUN_PH(7, phase_merge(p, bid, nb));
  RUN_PH(8, phase_wout(p, bid, nb));
  RUN_PH(9, phase_rowmid(p, bid, nb));
  RUN_PH(10, phase_ffn1(p, bid, nb));
  RUN_PH(11, phase_ffn2(p, bid, nb));
  RUN_PH(12, phase_final(p, bid, nb));
}

extern "C" void kernel_launch(void* const* d_in, const int* in_sizes, int n_in, void* d_out, int out_size, void* d_ws, size_t ws_size, hipStream_t stream) {
  (void)in_sizes; (void)n_in; (void)out_size;
  if (ws_size < WS_NEEDED) { fprintf(stderr, "workspace too small: %zu < %zu\n", ws_size, (size_t)WS_NEEDED); return; }
  P p{};
  const float** f = (const float**)&p;
  for (int i = 0; i < 31; ++i) f[i] = (const float*)d_in[i];
  p.out = (float*)d_out; p.ws = (char*)d_ws;
  static int grid_blocks = 0;
  if (!grid_blocks) {
    hipFuncSetAttribute((const void*)hybrid_layer_kernel, hipFuncAttributeMaxDynamicSharedMemorySize, SMEM_BYTES);
    int dev = 0, cus = 0, per_cu = 0;
    hipGetDevice(&dev);
    hipDeviceGetAttribute(&cus, hipDeviceAttributeMultiprocessorCount, dev);
    hipOccupancyMaxActiveBlocksPerMultiprocessor(&per_cu, hybrid_layer_kernel, NTHREADS, SMEM_BYTES);
    if (per_cu < 1) per_cu = 1;
    grid_blocks = cus * 1;
  }
#if SINGLE_LAUNCH
  int lo = 0, hi = NPHASE;
  void* args[] = {&p, &lo, &hi};
  hipError_t e = hipLaunchCooperativeKernel((void*)hybrid_layer_kernel, dim3(grid_blocks), dim3(NTHREADS), args, SMEM_BYTES, stream);
  if (e != hipSuccess) fprintf(stderr, "cooperative launch failed: %s (grid %d)\n", hipGetErrorString(e), grid_blocks);
#else
  for (int ph = 0; ph < NPHASE; ++ph) hybrid_layer_kernel<<<grid_blocks, NTHREADS, SMEM_BYTES, stream>>>(p, ph, ph + 1);
#endif
}
```

```cpp
#include <hip/hip_runtime.h>
#include <hip/hip_cooperative_groups.h>
#include <cstdio>
namespace cg = cooperative_groups;

#ifndef SINGLE_LAUNCH
#define SINGLE_LAUNCH 1
#endif

#define DI __device__ __forceinline__
#define LAS __attribute__((address_space(3)))
typedef unsigned short bf16_t;
typedef short bf16x8 __attribute__((ext_vector_type(8)));
typedef float f32x2 __attribute__((ext_vector_type(2)));
typedef float f32x4 __attribute__((ext_vector_type(4)));
typedef float f32x16 __attribute__((ext_vector_type(16)));
typedef unsigned u32x2 __attribute__((ext_vector_type(2)));
typedef unsigned u32x4 __attribute__((ext_vector_type(4)));
typedef __bf16 bfv2 __attribute__((ext_vector_type(2)));

constexpr int T = 32768, TC = 33280, SEQ = 16384, D = 2048;
constexpr size_t MiB = 1048576;
constexpr int SMEM_BYTES = 147456;
constexpr int NTHREADS = 512;

constexpr size_t OFF_MOD = 0, OFF_HDN = 1 * MiB, OFF_LR = 4 * MiB, OFF_DD = 10 * MiB;
constexpr size_t OFF_HX = 16 * MiB, OFF_WIN = 146 * MiB, OFF_HT = 187 * MiB, OFF_QKV = 315 * MiB, OFF_G = 445 * MiB, OFF_ZH = 509 * MiB;
constexpr size_t OFF_O = 701 * MiB, OFF_ZC = 829 * MiB, OFF_VT = 957 * MiB, OFF_QI = 16 * MiB, OFF_KST = 81 * MiB;
constexpr size_t OFF_FFTS = 315 * MiB, OFF_AM = 16 * MiB, OFF_W2 = 315 * MiB, OFF_MERGED = 187 * MiB, OFF_MIX = 445 * MiB;
constexpr size_t OFF_HX2 = 187 * MiB, OFF_HID = 573 * MiB, OFF_FFN = 16 * MiB;
constexpr size_t OFF_SLOC = 146 * MiB, OFF_DSEG = 180 * MiB;
constexpr size_t OFF_OFB = 187 * MiB;
constexpr size_t WS_NEEDED = 1022 * MiB;
constexpr size_t W2_PM = 0, W2_WOUT = 8388608, W2_WGU = 16777216, W2_WD = 16777216 + 46137344;

struct P {
  const float *x, *c, *ctx, *c_ctx, *w_ada, *b_ada, *n_pre_mix, *n_post_mix, *n_pre_ffn, *n_post_ffn, *w_in;
  const float *wg_f, *bg_f, *wg_b, *bg_b, *gla_norm, *short_w, *short_b, *emb_w, *emb_b, *mlp_w, *mlp_b, *freq, *out_w, *skip;
  const float *p_gla, *p_hy, *w_out, *ffn_gate, *ffn_up, *ffn_down;
  float* out; char* ws;
};

extern __shared__ __attribute__((aligned(16))) char g_smem[];

DI unsigned pk2(float lo, float hi) { f32x2 v = {lo, hi}; bfv2 r = __builtin_convertvector(v, bfv2); return __builtin_bit_cast(unsigned, r); }
DI bf16_t f2bf(float f) { __bf16 h = (__bf16)f; return __builtin_bit_cast(bf16_t, h); }
DI float bf2f(bf16_t h) { return __uint_as_float(((unsigned)h) << 16); }
DI float bflo(unsigned u) { return __uint_as_float(u << 16); }
DI float bfhi(unsigned u) { return __uint_as_float(u & 0xffff0000u); }
DI float wave_sum(float v) { for (int m = 32; m >= 1; m >>= 1) v += __shfl_xor(v, m, 64); return v; }
DI float sigmoidf_(float v) { return 1.f / (1.f + __expf(-v)); }
#define MFMA16(a, b, c) __builtin_amdgcn_mfma_f32_16x16x32_bf16((a), (b), (c), 0, 0, 0)
#define MFMA32(a, b, c) __builtin_amdgcn_mfma_f32_32x32x16_bf16((a), (b), (c), 0, 0, 0)

DI void wconv(const float* __restrict__ src, int ld, int K, int col0, int ncols, bf16_t* __restrict__ dst, int dstld, int drow0, int mode, int bid, int nb) {
  float* t = (float*)g_smem;
  const int tid = threadIdx.x;
  if ((ncols & 63) == 0) {
    const int ntn = ncols / 64, ntk = K / 64, nt = ntn * ntk;
    for (int it = bid; it < nt; it += nb) {
      const int tn = it % ntn, tk = it / ntn;
#pragma unroll
      for (int q = 0; q < 8; ++q) { int e = tid + 512 * q; int r = e >> 6, c = e & 63; t[r * 65 + c] = src[(size_t)(tk * 64 + r) * ld + col0 + tn * 64 + c]; }
      __syncthreads();
      { int n = tid >> 3, kk = (tid & 7) * 8; int cs = tn * 64 + n;
        int drow = mode == 0 ? drow0 + cs : ((cs >> 7) * 256 + drow0 + (cs & 127));
        u32x4 v; v.x = pk2(t[(kk) * 65 + n], t[(kk + 1) * 65 + n]); v.y = pk2(t[(kk + 2) * 65 + n], t[(kk + 3) * 65 + n]);
        v.z = pk2(t[(kk + 4) * 65 + n], t[(kk + 5) * 65 + n]); v.w = pk2(t[(kk + 6) * 65 + n], t[(kk + 7) * 65 + n]);
        *(u32x4*)(dst + (size_t)drow * dstld + tk * 64 + kk) = v; }
      __syncthreads();
    }
    return;
  }
  const int ntn = ncols / 32, ntk = K / 64, nt = ntn * ntk;
  for (int it = bid; it < nt; it += nb) {
    const int tn = it % ntn, tk = it / ntn;
#pragma unroll
    for (int q = 0; q < 4; ++q) { int e = tid + 512 * q; int r = e >> 5, c = e & 31; t[r * 33 + c] = src[(size_t)(tk * 64 + r) * ld + col0 + tn * 32 + c]; }
    __syncthreads();
    { int n = tid >> 4, kk = (tid & 15) * 4; int cs = tn * 32 + n;
      int drow = mode == 0 ? drow0 + cs : ((cs >> 7) * 256 + drow0 + (cs & 127));
      u32x2 v; v.x = pk2(t[(kk) * 33 + n], t[(kk + 1) * 33 + n]); v.y = pk2(t[(kk + 2) * 33 + n], t[(kk + 3) * 33 + n]);
      *(u32x2*)(dst + (size_t)drow * dstld + tk * 64 + kk) = v; }
    __syncthreads();
  }
}

DI void phase_prep(const P& p, int bid, int nb) {
  const int tid = threadIdx.x;
  {
    float* sl = (float*)(g_smem + 16384); float* red = sl + 3 * 2048;
    float* MOD = (float*)(p.ws + OFF_MOD);
    for (int it = bid; it < 192; it += nb) {
      for (int e = tid; e < 3 * 2048; e += 512) { int r = e >> 11, k = e & 2047; float v = r < 2 ? p.c[r * 2048 + k] : p.c_ctx[k]; sl[e] = v / (1.f + __expf(-v)); }
      __syncthreads();
      const int cgp = tid & 15, kg = tid >> 4; const int n0 = it * 64 + cgp * 4;
      f32x4 a0 = {0, 0, 0, 0}, a1 = a0, a2 = a0;
#pragma unroll 8
      for (int kk = 0; kk < 64; ++kk) { int k = kg * 64 + kk; f32x4 w = *(const f32x4*)(p.w_ada + (size_t)k * 12288 + n0); a0 += w * sl[k]; a1 += w * sl[2048 + k]; a2 += w * sl[4096 + k]; }
      *(f32x4*)(red + (kg * 3 + 0) * 64 + cgp * 4) = a0; *(f32x4*)(red + (kg * 3 + 1) * 64 + cgp * 4) = a1; *(f32x4*)(red + (kg * 3 + 2) * 64 + cgp * 4) = a2;
      __syncthreads();
      if (tid < 192) { int r = tid >> 6, c = tid & 63; float s = p.b_ada[it * 64 + c];
#pragma unroll 8
        for (int k2 = 0; k2 < 32; ++k2) s += red[(k2 * 3 + r) * 64 + c]; MOD[r * 12288 + it * 64 + c] = s; }
      __syncthreads();
    }
  }
  {
    float* zb = (float*)(g_smem + 16384); float* ha = zb + 8 * 36; float* hb = ha + 8 * 64;
    bf16_t* HDN = (bf16_t*)(p.ws + OFF_HDN);
    const int tl = tid >> 6, j = tid & 63;
    for (int it = bid; it < 2048; it += nb) {
      const int t = it * 8 + tl;
      if (j < 33) { float v; if (j == 0) v = (float)t * (1.f / 16383.f); else { int i = (j - 1) & 15; float fr = 1e-4f + (float)i * ((15.f - 1e-4f) / 15.f); float turns = fr * ((float)t * (1.f / 16384.f)); turns -= floorf(turns);
          v = (j <= 16) ? __builtin_amdgcn_cosf(turns) : -__builtin_amdgcn_sinf(turns); } zb[tl * 36 + j] = v; }
      __syncthreads();
      float acc = p.emb_b[j];
#pragma unroll 3
      for (int i = 0; i < 33; ++i) acc += zb[tl * 36 + i] * p.emb_w[i * 64 + j];
      ha[tl * 64 + j] = __sinf(p.freq[j] * acc);
      __syncthreads();
      acc = p.mlp_b[j];
#pragma unroll 8
      for (int i = 0; i < 64; ++i) acc += ha[tl * 64 + i] * p.mlp_w[i * 64 + j];
      hb[tl * 64 + j] = __sinf(p.freq[64 + j] * acc);
      __syncthreads();
      acc = p.mlp_b[64 + j];
#pragma unroll 8
      for (int i = 0; i < 64; ++i) acc += hb[tl * 64 + i] * p.mlp_w[4096 + i * 64 + j];
      HDN[(size_t)t * 64 + j] = f2bf(__sinf(p.freq[128 + j] * acc));
      __syncthreads();
    }
  }
}

DI void phase_pre(const P& p, int bid, int nb) {
  const int tid = threadIdx.x, wid = tid >> 6, lane = tid & 63;
  const float* MOD = (const float*)(p.ws + OFF_MOD);
  bf16_t* HX = (bf16_t*)(p.ws + OFF_HX);
  for (int row = bid * 8 + wid; row < TC; row += nb * 8) {
    const float* src; int mrow;
    if (row < T) { src = p.x + (size_t)row * D; mrow = row >> 14; } else { src = p.ctx + (size_t)(row - T) * D; mrow = 2; }
    f32x4 v[8]; float ss = 0.f;
#pragma unroll
    for (int q = 0; q < 8; ++q) { v[q] = *(const f32x4*)(src + q * 256 + lane * 4); ss += v[q].x * v[q].x + v[q].y * v[q].y + v[q].z * v[q].z + v[q].w * v[q].w; }
    ss = wave_sum(ss); const float rstd = rsqrtf(ss * (1.f / 2048.f) + 1e-6f);
    const float* sh = MOD + mrow * 12288; const float* sc = sh + 2048;
#pragma unroll
    for (int q = 0; q < 8; ++q) { int idx = q * 256 + lane * 4; f32x4 w = *(const f32x4*)(p.n_pre_mix + idx), s1 = *(const f32x4*)(sc + idx), h1 = *(const f32x4*)(sh + idx);
      f32x4 y = v[q] * rstd * w * (1.f + s1) + h1; u32x2 o; o.x = pk2(y.x, y.y); o.y = pk2(y.z, y.w); *(u32x2*)(HX + (size_t)row * D + idx) = o; }
  }
  {
    const int fr = lane & 15, fq = lane >> 4;
    const bf16_t* HDN = (const bf16_t*)(p.ws + OFF_HDN); float* HT = (float*)(p.ws + OFF_HT);
    for (int id = bid * 8 + wid; id < 128 * 64; id += nb * 8) {
      const int mt = id & 127, ng = id >> 7; const int ch = mt * 16 + fr;
      bf16x8 a[2];
#pragma unroll
      for (int s = 0; s < 2; ++s)
#pragma unroll
        for (int i = 0; i < 8; ++i) a[s][i] = (short)f2bf(p.out_w[(size_t)(s * 32 + fq * 8 + i) * 2048 + ch]);
      const float lo = -120.39728043259361f, hi = 40.546510810816436f;
      const float delta = fabsf(lo + (float)(ch & 1023) * ((hi - lo) / 1023.f));
      for (int q = 0; q < 16; ++q) {
        const int n0 = (ng * 16 + q) * 16;
        bf16x8 b0 = *(const bf16x8*)(HDN + (size_t)(n0 + fr) * 64 + fq * 8), b1 = *(const bf16x8*)(HDN + (size_t)(n0 + fr) * 64 + 32 + fq * 8);
        f32x4 acc = {0, 0, 0, 0};
        acc = MFMA16(b0, a[0], acc); acc = MFMA16(b1, a[1], acc);
#pragma unroll
        for (int jj = 0; jj < 4; ++jj) { float tl = (float)(n0 + 4 * fq + jj) * (1.f / 16383.f); acc[jj] *= __expf(-tl * delta); }
        *(f32x4*)(HT + (size_t)ch * 16384 + n0 + 4 * fq) = acc;
      }
    }
  }
  bf16_t* WIN = (bf16_t*)(p.ws + OFF_WIN);
#pragma unroll 1
  for (int job = 0; job < 7; ++job) {
    int col0, ncols, drow0, mode = 0;
    switch (job) { case 0: col0 = 0; ncols = 2048; drow0 = 0; break; case 1: col0 = 2080; ncols = 1024; drow0 = 2048; break;
      case 2: col0 = 3104; ncols = 1024; drow0 = 3072; break;
      case 3: col0 = 4128; ncols = 1024; drow0 = 4096; mode = 1; break;
      case 4: col0 = 5152; ncols = 1024; drow0 = 4096 + 128; mode = 1; break;
      case 5: col0 = 6176; ncols = 4096; drow0 = 6144; break; default: col0 = 2048; ncols = 32; drow0 = 10240; break; }
    wconv(p.w_in, 10272, 2048, col0, ncols, WIN, 2048, drow0, mode, bid, nb);
  }
  for (size_t e = (size_t)bid * 512 + tid; e < (size_t)224 * 2048 / 8; e += (size_t)nb * 512) ((u32x4*)(WIN + (size_t)10272 * 2048))[e] = (u32x4){0u, 0u, 0u, 0u};
}

DI int lds_byte(int r, int c) { int st = (r >> 4) * 2 + (c >> 5), rr = r & 15, cc = c & 31, ob = rr * 64 + cc * 2; return st * 1024 + (ob ^ (((ob >> 9) & 1) << 5)); }
DI void stage_rc(int b, int& R, int& C) { int st = b / 1024, sb = b % 1024, swz = sb ^ (((sb >> 9) & 1) << 5); R = (st >> 1) * 16 + swz / 64; C = (st & 1) * 32 + (swz % 64) / 2; }
DI int perm32(int rho) { const int n = rho >> 4, i = rho & 15; return 8 * (i >> 2) + 4 * n + (i & 3); }
DI void unit_order(int L, int nM, int nN, int& pm, int& pn) {
  const int nwg = nM * nN; int wgid = L;
  { const int q = nwg / 8, r = nwg % 8, xcd = wgid % 8, off = wgid / 8; wgid = (xcd < r ? xcd * (q + 1) : r * (q + 1) + (xcd - r) * q) + off; }
  const int nig = 8 * nN, gid = wgid / nig, fm = gid * 8, gsz = (nM - fm) < 8 ? (nM - fm) : 8;
  pm = fm + ((wgid % nig) % gsz); pn = (wgid % nig) / gsz;
}

struct Unit { const char* a; const char* b; int pm, pn, tag; };
template <class Sched, class Epi>
DI void gemm_stream(const long lda, const long ldb, const int K, const Sched& S, const Epi& E) {
  LAS unsigned char* lds = (LAS unsigned char*)g_smem;
  constexpr int HTB = 128 * 64 * 2;
  const int tid = threadIdx.x, wid = __builtin_amdgcn_readfirstlane(tid >> 6), lane = tid & 63, wr = wid >> 2, wc = wid & 3, fr = lane & 15, fq = lane >> 4;
  const int nt = K / 64;
  unsigned voffA[2], voffB[2];
#pragma unroll
  for (int i = 0; i < 2; ++i) { int R, C; stage_rc(tid * 16 + i * 8192, R, C); const int Rb = (R & ~31) + perm32(R & 31);
    voffA[i] = (unsigned)(R * (int)lda + C) * 2u; voffB[i] = (unsigned)(Rb * (int)ldb + C) * 2u; }
  const size_t kstep = 128, hstepA = (size_t)128 * lda * 2, hstepB = (size_t)128 * ldb * 2;
  const unsigned ldsw = (unsigned)wid * 1024u;
  const int aoff = lds_byte(wr * 64 + fr, fq * 8), boff = lds_byte(wc * 32 + fr, fq * 8);
#define G_SA(b, h) (((b) * 2 + (h)) * HTB)
#define G_SB(b, h) ((4 + (b) * 2 + (h)) * HTB)
#define G_STAGE(bufoff, gbase, voff) do { _Pragma("unroll") for (int _i = 0; _i < 2; ++_i) \
    __builtin_amdgcn_global_load_lds((const unsigned*)((const char*)(gbase) + (voff)[_i]), (LAS unsigned*)(lds + (bufoff) + ldsw + _i * 8192), 16, 0, 0); } while (0)
#define G_LDA(dst, b, h) do { _Pragma("unroll") for (int m = 0; m < 4; ++m) _Pragma("unroll") for (int k = 0; k < 2; ++k) dst[m][k] = *(const LAS bf16x8*)(lds + G_SA(b, h) + aoff + m * 2048 + k * 1024); } while (0)
#define G_LDB(dst, b, h) do { _Pragma("unroll") for (int n = 0; n < 2; ++n) _Pragma("unroll") for (int k = 0; k < 2; ++k) dst[n][k] = *(const LAS bf16x8*)(lds + G_SB(b, h) + boff + n * 2048 + k * 1024); } while (0)
#define G_MMA(ai, bj, At_, Bt_) do { __builtin_amdgcn_s_setprio(1); _Pragma("unroll") for (int m = 0; m < 4; ++m) _Pragma("unroll") for (int n = 0; n < 2; ++n) _Pragma("unroll") for (int k = 0; k < 2; ++k) \
    acc[ai][bj][m][n] = MFMA16(Bt_[n][k], At_[m][k], acc[ai][bj][m][n]); __builtin_amdgcn_s_setprio(0); } while (0)
#define G_WAIT_V(n) asm volatile("s_waitcnt vmcnt(" #n ")" ::: "memory")
#define G_WAIT_L(n) asm volatile("s_waitcnt lgkmcnt(" #n ")" ::: "memory")
#define G_BAR __builtin_amdgcn_s_barrier()
#define G_SCHED __builtin_amdgcn_sched_barrier(0)
  Unit cur, nxt; int ui = 0;
  if (!S.next(0, cur)) return;
  f32x4 acc[2][2][4][2];
#pragma unroll
  for (int a = 0; a < 2; ++a)
#pragma unroll
    for (int b = 0; b < 2; ++b)
#pragma unroll
      for (int m = 0; m < 4; ++m)
#pragma unroll
        for (int n = 0; n < 2; ++n) acc[a][b][m][n] = (f32x4){0.f, 0.f, 0.f, 0.f};
  bf16x8 At[4][2], B0[2][2], B1[2][2];
  const char* cA = cur.a; const char* cB = cur.b;
  G_WAIT_V(0);
  G_STAGE(G_SB(0, 0), cB, voffB); G_STAGE(G_SA(0, 0), cA, voffA); G_STAGE(G_SB(0, 1), cB + hstepB, voffB); G_STAGE(G_SA(0, 1), cA + hstepA, voffA);
  if (wr == 1) G_BAR;
  G_WAIT_V(4); G_BAR;
  G_STAGE(G_SB(1, 0), cB + kstep, voffB); G_STAGE(G_SA(1, 0), cA + kstep, voffA); G_STAGE(G_SB(1, 1), cB + hstepB + kstep, voffB);
  G_WAIT_V(6); G_BAR;
  for (;;) {
    const bool has_next = S.next(ui + 1, nxt);
    const char* nA = has_next ? nxt.a : cA; const char* nB = has_next ? nxt.b : cB;
#pragma unroll 1
    for (int t = 0; t < nt; t += 2) {
      const bool last = (t == nt - 2);
      const char* a1 = cA + (size_t)(t + 1) * kstep;
      const char* a2 = last ? nA : cA + (size_t)(t + 2) * kstep; const char* b2 = last ? nB : cB + (size_t)(t + 2) * kstep;
      const char* a3 = a2 + kstep; const char* b3 = b2 + kstep;
      G_LDB(B0, 0, 0); G_SCHED; G_LDA(At, 0, 0); G_STAGE(G_SA(1, 1), a1 + hstepA, voffA);
      G_WAIT_L(8); G_BAR; G_WAIT_L(0); G_MMA(0, 0, At, B0); G_BAR; G_SCHED;
      G_LDB(B1, 0, 1); G_STAGE(G_SB(0, 0), b2, voffB);
      G_BAR; G_WAIT_L(0); G_MMA(0, 1, At, B1); G_BAR;
      G_LDA(At, 0, 1); G_STAGE(G_SA(0, 0), a2, voffA);
      G_BAR; G_WAIT_L(0); G_MMA(1, 0, At, B0); G_BAR; G_SCHED;
      G_STAGE(G_SB(0, 1), b2 + hstepB, voffB);
      G_WAIT_V(6); G_BAR; G_MMA(1, 1, At, B1); G_BAR;
      G_LDB(B0, 1, 0); G_SCHED; G_LDA(At, 1, 0); G_STAGE(G_SA(0, 1), a2 + hstepA, voffA);
      G_WAIT_L(8); G_BAR; G_WAIT_L(0); G_MMA(0, 0, At, B0); G_BAR; G_SCHED;
      G_LDB(B1, 1, 1); G_STAGE(G_SB(1, 0), b3, voffB);
      G_BAR; G_WAIT_L(0); G_MMA(0, 1, At, B1); G_BAR;
      G_LDA(At, 1, 1); G_STAGE(G_SA(1, 0), a3, voffA);
      G_BAR; G_WAIT_L(0); G_MMA(1, 0, At, B0); G_BAR; G_SCHED;
      G_STAGE(G_SB(1, 1), b3 + hstepB, voffB);
      G_WAIT_V(6); G_BAR; G_MMA(1, 1, At, B1); G_BAR;
    }
    E(acc, cur, wr, wc, fr, fq);
    if (!has_next) break;
    if (!(nxt.tag & 1)) {
#pragma unroll
      for (int a = 0; a < 2; ++a)
#pragma unroll
        for (int b = 0; b < 2; ++b)
#pragma unroll
          for (int m = 0; m < 4; ++m)
#pragma unroll
            for (int n = 0; n < 2; ++n) acc[a][b][m][n] = (f32x4){0.f, 0.f, 0.f, 0.f};
    }
    cur = nxt; cA = nA; cB = nB; ++ui;
  }
  G_WAIT_V(0);
  if (wr == 0) G_BAR;
  G_BAR;
}

struct GridSched {
  const bf16_t* A; const bf16_t* Bt; long lda, ldb; int nM, nN, bid, nb;
  DI bool next(int i, Unit& u) const { const int L = i * nb + bid; if (L >= nM * nN) return false; unit_order(L, nM, nN, u.pm, u.pn);
    u.a = (const char*)(A + (size_t)u.pm * 256 * lda); u.b = (const char*)(Bt + (size_t)u.pn * 256 * ldb); u.tag = 0; return true; }
};

DI void zero_acc(f32x4 (&acc)[2][2][4][2]) {
#pragma unroll
  for (int a = 0; a < 2; ++a)
#pragma unroll
    for (int b = 0; b < 2; ++b)
#pragma unroll
      for (int m = 0; m < 4; ++m)
#pragma unroll
        for (int n = 0; n < 2; ++n) acc[a][b][m][n] = (f32x4){0.f, 0.f, 0.f, 0.f};
}

template <int ACT>
DI void store_tile_bf16(const f32x4 (&acc)[2][2][4][2], bf16_t* dst, long ld, int brow, int col0, float scale, int wr, int wc, int fr, int fq) {
#pragma unroll
  for (int ai = 0; ai < 2; ++ai)
#pragma unroll
    for (int m = 0; m < 4; ++m) {
      bf16_t* rp = dst + (long)(brow + ai * 128 + wr * 64 + m * 16 + fr) * ld + col0 + wc * 32 + 8 * fq;
#pragma unroll
      for (int bj = 0; bj < 2; ++bj) {
        f32x4 v0 = acc[ai][bj][m][0], v1 = acc[ai][bj][m][1];
        if (ACT == 1) { v0 *= scale; v1 *= scale; }
        if (ACT == 2) {
#pragma unroll
          for (int j = 0; j < 4; ++j) { v0[j] = v0[j] * sigmoidf_(v0[j]); v1[j] = v1[j] * sigmoidf_(v1[j]); } }
        u32x4 w; w.x = pk2(v0[0], v0[1]); w.y = pk2(v0[2], v0[3]); w.z = pk2(v1[0], v1[1]); w.w = pk2(v1[2], v1[3]);
        *(u32x4*)(rp + bj * 128) = w;
      }
    }
}

struct Gemm1Sched { const bf16_t* A; const bf16_t* Bt; int bid, nb;
  DI bool next(int i, Unit& u) const { const int L = i * nb + bid; const int nmain = 128 * 41; if (L >= nmain + 18) return false;
    if (L < nmain) unit_order(L, 128, 41, u.pm, u.pn); else { int e = L - nmain; u.pm = 128 + e / 9; int c = e % 9; u.pn = c < 8 ? c : 40; }
    u.a = (const char*)(A + (size_t)u.pm * 256 * 2048); u.b = (const char*)(Bt + (size_t)u.pn * 256 * 2048); u.tag = 0; return true; } };
DI void phase_gemm1(const P& p, int bid, int nb) {
  const bf16_t* HX = (const bf16_t*)(p.ws + OFF_HX); const bf16_t* WIN = (const bf16_t*)(p.ws + OFF_WIN);
  bf16_t* QKV = (bf16_t*)(p.ws + OFF_QKV); bf16_t* G = (bf16_t*)(p.ws + OFF_G); bf16_t* ZH = (bf16_t*)(p.ws + OFF_ZH); bf16_t* MG = (bf16_t*)p.out;
  float* LR = (float*)(p.ws + OFF_LR);
  Gemm1Sched S{HX, WIN, bid, nb};
  auto E = [&](f32x4 (&acc)[2][2][4][2], const Unit& u, int wr, int wc, int fr, int fq) {
    const int brow = u.pm * 256, pn = u.pn;
    if (pn < 2) store_tile_bf16<1>(acc, QKV, 2048, brow, pn * 256, 0.08838834764831845f, wr, wc, fr, fq);
    else if (pn < 8) store_tile_bf16<0>(acc, QKV, 2048, brow, pn * 256, 1.f, wr, wc, fr, fq);
    else if (pn < 12) store_tile_bf16<2>(acc, G, 1024, brow, (pn - 8) * 256, 1.f, wr, wc, fr, fq);
    else if (pn < 16) store_tile_bf16<0>(acc, ZH, 1024, brow, (pn - 12) * 256, 1.f, wr, wc, fr, fq);
    else if (pn < 24) {
      const int lane = threadIdx.x & 63; const int cb = (pn - 16) * 128 + wc * 32 + 8 * fq;
      const int upsrc = (lane & ~15) | ((fr - 1) & 15), dnsrc = (lane & ~15) | ((fr + 1) & 15);
      float* ZCf = (float*)(p.ws + OFF_ZC);
#pragma unroll
      for (int n = 0; n < 2; ++n)
#pragma unroll
        for (int jj = 0; jj < 4; ++jj) { const int c = cb + 4 * n + jj;
          const float a0 = p.short_w[1024 + c], a1 = p.short_w[3072 + 1024 + c], a2 = p.short_w[6144 + 1024 + c], ab = p.short_b[1024 + c];
          const float v0 = p.short_w[2048 + c], v1 = p.short_w[3072 + 2048 + c], v2 = p.short_w[6144 + 2048 + c], vbias = p.short_b[2048 + c];
#pragma unroll
          for (int ai = 0; ai < 2; ++ai) { const int t0 = brow + ai * 128 + wr * 64; const int bb = t0 >> 14, tin = t0 & 16383;
            float xr[4], vr[4], xu[4], vu[4], xd[4], vd[4];
#pragma unroll
            for (int m = 0; m < 4; ++m) { xr[m] = acc[ai][0][m][n][jj]; vr[m] = acc[ai][1][m][n][jj];
              xu[m] = __shfl(xr[m], upsrc, 64); vu[m] = __shfl(vr[m], upsrc, 64); xd[m] = __shfl(xr[m], dnsrc, 64); vd[m] = __shfl(vr[m], dnsrc, 64); }
            float* zp = ZCf + ((size_t)bb * 1024 + c) * 16384 + tin + fr;
#pragma unroll
            for (int m = 0; m < 4; ++m) {
              const float xup = fr > 0 ? xu[m] : (m > 0 ? xu[m - 1] : 0.f), vup = fr > 0 ? vu[m] : (m > 0 ? vu[m - 1] : 0.f);
              const float xdn = fr < 15 ? xd[m] : (m < 3 ? xd[m + 1] : 0.f), vdn = fr < 15 ? vd[m] : (m < 3 ? vd[m + 1] : 0.f);
              const float ux = a0 * xup + a1 * xr[m] + a2 * xdn + ab, uv = v0 * vup + v1 * vr[m] + v2 * vdn + vbias;
              zp[16 * m] = ux * uv; } } }
    }
    else if (pn < 40) store_tile_bf16<0>(acc, MG, 4096, brow, (pn - 24) * 256, 1.f, wr, wc, fr, fq);
    else if (wc == 0) {
#pragma unroll
      for (int ai = 0; ai < 2; ++ai)
#pragma unroll
        for (int m = 0; m < 4; ++m) { float* rp = LR + (size_t)(brow + ai * 128 + wr * 64 + m * 16 + fr) * 32 + 8 * fq;
          *(f32x4*)(rp) = acc[ai][0][m][0]; *(f32x4*)(rp + 4) = acc[ai][0][m][1]; }
    }
  };
  gemm_stream(2048, 2048, 2048, S, E);
}

DI void phase_local(const P& p, int bid, int nb) {
  const int tid = threadIdx.x, wid = tid >> 6, lane = tid & 63, fr = lane & 15, fq = lane >> 4;
  float* bL = (float*)g_smem;
  bf16_t* Qs = (bf16_t*)(g_smem + 33280);
  bf16_t* Ks = Qs + 64 * 136;
  bf16_t* KT = Ks + 64 * 136;
  bf16_t* Pm = KT + 128 * 72;
  bf16_t* VTl = Pm + 64 * 136;
  float* tot = (float*)(VTl + 256 * 72);
  float* wgL = (float*)KT;
  const bf16_t* QKV = (const bf16_t*)(p.ws + OFF_QKV); const float* LR = (const float*)(p.ws + OFF_LR);
  bf16_t* QI = (bf16_t*)(p.ws + OFF_QI); bf16_t* KST = (bf16_t*)(p.ws + OFF_KST); bf16_t* VT = (bf16_t*)(p.ws + OFF_VT);
  float* DD = (float*)(p.ws + OFF_DD); bf16_t* O = (bf16_t*)(p.ws + OFF_O);
  for (int u = bid; u < 2080; u += nb) {
    int b, n, hd; size_t row0; const bool isctx = u >= 2048;
    if (!isctx) { hd = u & 3; n = (u >> 2) & 255; b = u >> 10; row0 = (size_t)b * 16384 + n * 64; }
    else { int v = u - 2048; hd = v & 3; n = (v >> 2) & 3; b = v >> 4; row0 = (size_t)T + b * 256 + n * 64; }
    { const bf16_t* vp = QKV + (row0 + lane) * 2048 + 1024 + hd * 256 + wid * 32;
#pragma unroll
      for (int q = 0; q < 4; ++q) { bf16x8 v = *(const bf16x8*)(vp + q * 8);
#pragma unroll
        for (int e = 0; e < 8; ++e) VTl[(wid * 32 + q * 8 + e) * 72 + lane] = (bf16_t)v[e]; } }
    for (int dir = 0; dir < 2; ++dir) {
      { const float* wg = dir ? p.wg_b : p.wg_f; const float* bg = dir ? p.bg_b : p.bg_f;
        *(f32x4*)(wgL + (tid >> 5) * 128 + (tid & 31) * 4) = *(const f32x4*)(wg + (tid >> 5) * 512 + hd * 128 + (tid & 31) * 4);
        if (tid < 128) wgL[2048 + tid] = bg[hd * 128 + tid]; }
      __syncthreads();
      { const float* lr = LR + (row0 + lane) * 32 + dir * 16;
        f32x4 l0 = *(const f32x4*)(lr), l1 = *(const f32x4*)(lr + 4), l2 = *(const f32x4*)(lr + 8), l3 = *(const f32x4*)(lr + 12);
#pragma unroll 4
        for (int e = 0; e < 16; ++e) { const int dk = wid * 16 + e; float z = wgL[2048 + dk];
#pragma unroll
          for (int r = 0; r < 4; ++r) z += l0[r] * wgL[r * 128 + dk] + l1[r] * wgL[(4 + r) * 128 + dk] + l2[r] * wgL[(8 + r) * 128 + dk] + l3[r] * wgL[(12 + r) * 128 + dk];
          bL[lane * 129 + dk] = (fminf(z, 0.f) - __logf(1.f + __expf(-fabsf(z)))) * (1.f / 16.f); } }
      __syncthreads();
      { const int col = tid & 127, seg = tid >> 7; float a = 0.f;
#pragma unroll
        for (int i = 0; i < 16; ++i) { const int row = dir ? (seg * 16 + 15 - i) : (seg * 16 + i); a += bL[row * 129 + col]; bL[row * 129 + col] = a; }
        tot[seg * 128 + col] = a; }
      __syncthreads();
      { const int col = tid & 127, seg = tid >> 7; float off = 0.f;
#pragma unroll
        for (int s2 = 0; s2 < 4; ++s2) { const bool use = dir ? (s2 > seg) : (s2 < seg); if (use) off += tot[s2 * 128 + col]; }
#pragma unroll
        for (int i = 0; i < 16; ++i) bL[(seg * 16 + i) * 129 + col] += off; }
      __syncthreads();
      { const int j = lane;
        const bf16_t* qp = QKV + (row0 + j) * 2048 + hd * 128 + wid * 16; const bf16_t* kp = qp + 512;
        bf16x8 q0 = *(const bf16x8*)qp, q1 = *(const bf16x8*)(qp + 8), k0 = *(const bf16x8*)kp, k1 = *(const bf16x8*)(kp + 8);
        const int jref = dir ? 32 : 31, jlast = dir ? 0 : 63;
        float qiv[16], qsv[16], ksv[16];
#pragma unroll
        for (int e = 0; e < 16; ++e) { const int dk = wid * 16 + e; float bq = bL[j * 129 + dk], br = bL[jref * 129 + dk], bl = bL[jlast * 129 + dk];
          float qv = bf2f((bf16_t)(e < 8 ? q0[e & 7] : q1[e & 7])), kv = bf2f((bf16_t)(e < 8 ? k0[e & 7] : k1[e & 7]));
          qsv[e] = qv * __expf(bq - br); ksv[e] = kv * __expf(br - bq);
          qiv[e] = qv * __expf(bq); KT[dk * 72 + j] = f2bf(kv * __expf(bl - bq));
          if (j == jlast) DD[((size_t)u * 2 + dir) * 128 + dk] = __expf(bl); }
        u32x4 w0, w1;
        w0.x = pk2(qsv[0], qsv[1]); w0.y = pk2(qsv[2], qsv[3]); w0.z = pk2(qsv[4], qsv[5]); w0.w = pk2(qsv[6], qsv[7]);
        w1.x = pk2(qsv[8], qsv[9]); w1.y = pk2(qsv[10], qsv[11]); w1.z = pk2(qsv[12], qsv[13]); w1.w = pk2(qsv[14], qsv[15]);
        *(u32x4*)(Qs + j * 136 + wid * 16) = w0; *(u32x4*)(Qs + j * 136 + wid * 16 + 8) = w1;
        w0.x = pk2(ksv[0], ksv[1]); w0.y = pk2(ksv[2], ksv[3]); w0.z = pk2(ksv[4], ksv[5]); w0.w = pk2(ksv[6], ksv[7]);
        w1.x = pk2(ksv[8], ksv[9]); w1.y = pk2(ksv[10], ksv[11]); w1.z = pk2(ksv[12], ksv[13]); w1.w = pk2(ksv[14], ksv[15]);
        *(u32x4*)(Ks + j * 136 + wid * 16) = w0; *(u32x4*)(Ks + j * 136 + wid * 16 + 8) = w1;
        w0.x = pk2(qiv[0], qiv[1]); w0.y = pk2(qiv[2], qiv[3]); w0.z = pk2(qiv[8], qiv[9]); w0.w = pk2(qiv[10], qiv[11]);
        w1.x = pk2(qiv[4], qiv[5]); w1.y = pk2(qiv[6], qiv[7]); w1.z = pk2(qiv[12], qiv[13]); w1.w = pk2(qiv[14], qiv[15]);
        bf16_t* qo = QI + (((size_t)u * 2 + dir) * 64 + j) * 128 + wid * 16;
        *(u32x4*)qo = w0; *(u32x4*)(qo + 8) = w1; }
      __syncthreads();
      { const int ti = wid >> 1, tj0 = 2 * (wid & 1);
#pragma unroll
        for (int tt = 0; tt < 2; ++tt) { const int tj = tj0 + tt; f32x4 acc = {0, 0, 0, 0};
#pragma unroll
          for (int s = 0; s < 4; ++s) { bf16x8 a = *(const bf16x8*)(Qs + (16 * ti + fr) * 136 + 32 * s + 8 * fq), bb = *(const bf16x8*)(Ks + (16 * tj + fr) * 136 + 32 * s + 8 * fq);
            acc = MFMA16(bb, a, acc); }
          const int i = 16 * ti + fr;
#pragma unroll
          for (int jj = 0; jj < 4; ++jj) { int jc = 16 * tj + 4 * fq + jj; bool keep = dir ? (jc >= i) : (jc <= i); if (!keep) acc[jj] = 0.f; }
          u32x2 w; w.x = pk2(acc[0], acc[1]); w.y = pk2(acc[2], acc[3]);
          *(u32x2*)(Pm + i * 136 + dir * 64 + 16 * tj + 4 * fq) = w; }
        const int dk = tid >> 2, part = tid & 3;
        bf16_t* ko = KST + (((size_t)u * 2 + dir) * 128 + dk) * 64 + part * 16;
        *(u32x4*)ko = *(const u32x4*)(KT + dk * 72 + part * 16); *(u32x4*)(ko + 8) = *(const u32x4*)(KT + dk * 72 + part * 16 + 8); }
      __syncthreads();
    }
    { const int dv = tid >> 1, part = tid & 1; bf16_t* vo = VT + ((size_t)u * 256 + dv) * 64 + part * 32;
#pragma unroll
      for (int q = 0; q < 4; ++q) *(u32x4*)(vo + q * 8) = *(const u32x4*)(VTl + dv * 72 + part * 32 + q * 8); }
    if (!isctx) {
#pragma unroll
      for (int tt = 0; tt < 2; ++tt) { const int tn = 2 * wid + tt;
        bf16x8 bfv[4];
#pragma unroll
        for (int s = 0; s < 4; ++s) bfv[s] = *(const bf16x8*)(VTl + (16 * tn + fr) * 72 + ((32 * s + 8 * fq) & 63));
#pragma unroll
        for (int ti = 0; ti < 4; ++ti) { f32x4 acc = {0, 0, 0, 0};
#pragma unroll
          for (int s = 0; s < 4; ++s) { bf16x8 a = *(const bf16x8*)(Pm + (16 * ti + fr) * 136 + 32 * s + 8 * fq); acc = MFMA16(bfv[s], a, acc); }
          u32x2 w; w.x = pk2(acc[0], acc[1]); w.y = pk2(acc[2], acc[3]);
          *(u32x2*)(O + (row0 + 16 * ti + fr) * 1024 + hd * 256 + 16 * tn + 4 * fq) = w; } }
    }
    __syncthreads();
  }
}

DI int fpad(int n) { return n + (n >> 4); }
DI int otid() { int t = threadIdx.x; asm volatile("" : "+v"(t)); return t; }
DI f32x2 cmul(f32x2 a, f32x2 b) { return (f32x2){a.x * b.x - a.y * b.y, a.x * b.y + a.y * b.x}; }
DI f32x2 cmulc(f32x2 a, f32x2 b) { return (f32x2){a.x * b.x + a.y * b.y, a.y * b.x - a.x * b.y}; }
DI f32x2 twid(float frac) { return (f32x2){__builtin_amdgcn_cosf(frac), -__builtin_amdgcn_sinf(frac)}; }
template <bool INV> DI void dft4(f32x2& a, f32x2& b, f32x2& c, f32x2& d) {
  f32x2 s0 = a + c, s1 = a - c, s2 = b + d, s3 = b - d;
  f32x2 t = INV ? (f32x2){-s3.y, s3.x} : (f32x2){s3.y, -s3.x};
  a = s0 + s2; c = s0 - s2; b = s1 + t; d = s1 - t;
}
template <bool INV> DI void dft16(f32x2 (&x)[16]) {
  constexpr float CS[10] = {1.f, 0.9238795325112867f, 0.7071067811865476f, 0.3826834323650898f, 0.f, -0.3826834323650898f, -0.7071067811865476f, -0.9238795325112867f, -1.f, -0.9238795325112867f};
  constexpr float SN[10] = {0.f, 0.3826834323650898f, 0.7071067811865476f, 0.9238795325112867f, 1.f, 0.9238795325112867f, 0.7071067811865476f, 0.3826834323650898f, 0.f, -0.3826834323650898f};
#pragma unroll
  for (int a = 0; a < 4; ++a) dft4<INV>(x[a], x[a + 4], x[a + 8], x[a + 12]);
#pragma unroll
  for (int a = 1; a < 4; ++a)
#pragma unroll
    for (int c = 1; c < 4; ++c) { const int m = a * c; f32x2 w = {CS[m], INV ? SN[m] : -SN[m]}; x[a + 4 * c] = cmul(x[a + 4 * c], w); }
#pragma unroll
  for (int c = 0; c < 4; ++c) dft4<INV>(x[4 * c], x[4 * c + 1], x[4 * c + 2], x[4 * c + 3]);
}
#define OIDX(k) (4 * ((k) & 3) + ((k) >> 2))

DI void twpow(f32x2 w1, f32x2 (&w)[16]) {
  w[1] = w1; w[2] = cmul(w1, w1); w[4] = cmul(w[2], w[2]); w[8] = cmul(w[4], w[4]);
  w[3] = cmul(w[2], w[1]); w[5] = cmul(w[4], w[1]); w[6] = cmul(w[4], w[2]); w[7] = cmul(w[4], w[3]);
  w[9] = cmul(w[8], w[1]); w[10] = cmul(w[8], w[2]); w[11] = cmul(w[8], w[3]); w[12] = cmul(w[8], w[4]);
  w[13] = cmul(w[8], w[5]); w[14] = cmul(w[8], w[6]); w[15] = cmul(w[8], w[7]);
}
template <bool INV> DI void pass16(f32x2* X, int id, int ls) {
  const int s = 1 << ls, n0 = id & (s - 1), base = (id >> ls) << (ls + 4);
  f32x2 w[16]; twpow(twid((float)n0 / (float)(16 << ls)), w);
  f32x2 v[16];
#pragma unroll
  for (int k = 0; k < 16; ++k) v[k] = X[fpad(base + k * s + n0)];
  if (INV) {
#pragma unroll
    for (int k = 1; k < 16; ++k) v[k] = cmulc(v[k], w[k]);
    dft16<true>(v);
#pragma unroll
    for (int k = 0; k < 16; ++k) X[fpad(base + k * s + n0)] = v[OIDX(k)];
  } else {
    dft16<false>(v);
#pragma unroll
    for (int k = 0; k < 16; ++k) { f32x2 y = v[OIDX(k)]; if (k) y = cmul(y, w[k]); X[fpad(base + k * s + n0)] = y; }
  }
}
DI void fft_fwd23(f32x2* X) {
  __syncthreads();
  { const int tid = otid();
#pragma unroll
  for (int q = 0; q < 2; ++q) pass16<false>(X, tid + 512 * q, 8); }
  __syncthreads();
  { const int tid = otid();
#pragma unroll
  for (int q = 0; q < 2; ++q) pass16<false>(X, tid + 512 * q, 4); }
  __syncthreads();
}
DI void f1_store(f32x2* X, int n0, f32x2 a, f32x2 b, f32x2 c, f32x2 d) {
  dft4<false>(a, b, c, d);
  f32x2 w1 = twid((float)n0 * (1.f / 16384.f)), w2 = cmul(w1, w1), w3 = cmul(w2, w1);
  X[fpad(n0)] = a; X[fpad(4096 + n0)] = cmul(b, w1); X[fpad(8192 + n0)] = cmul(c, w2); X[fpad(12288 + n0)] = cmul(d, w3);
}

DI void fft_channel(const P& p, int c, f32x2* G1, f32x2* G2, f32x2* G3) {
  f32x2* X = (f32x2*)g_smem;
  const float* hf = (const float*)(p.ws + OFF_HT) + (size_t)c * 16384; const float* hb = hf + (size_t)1024 * 16384;
  float* zc0 = (float*)(p.ws + OFF_ZC) + (size_t)c * 16384; float* zc1 = zc0 + (size_t)1024 * 16384;
  const float skip = p.skip[c];
  const float R2 = 0.7071067811865476f;
#pragma unroll 1
  for (int rnd = 0; rnd < 2; ++rnd) {
#pragma unroll 1
    for (int q0 = 0; q0 < 8; q0 += 4) {
      const int tid = otid();
      float f[4][4], g[4][4];
#pragma unroll
      for (int qq = 0; qq < 4; ++qq)
#pragma unroll
        for (int jx = 0; jx < 4; ++jx) { const int n = tid + 512 * (q0 + qq) + 4096 * jx; f[qq][jx] = hf[n]; g[qq][jx] = n ? hb[16384 - n] : 0.f; }
#pragma unroll
      for (int qq = 0; qq < 4; ++qq) { const int n0 = tid + 512 * (q0 + qq); f32x2 v[4];
        if (rnd == 0) {
#pragma unroll
          for (int jx = 0; jx < 4; ++jx) v[jx] = (f32x2){f[qq][jx] + g[qq][jx], 0.f};
        } else { const f32x2 w0 = twid((float)n0 * (1.f / 32768.f));
          const f32x2 w1 = cmul(w0, (f32x2){R2, -R2}), w2 = (f32x2){w0.y, -w0.x}, w3 = cmul(w0, (f32x2){-R2, -R2});
          v[0] = w0 * (f[qq][0] - g[qq][0]); v[1] = w1 * (f[qq][1] - g[qq][1]); v[2] = w2 * (f[qq][2] - g[qq][2]); v[3] = w3 * (f[qq][3] - g[qq][3]); }
        f1_store(X, n0, v[0], v[1], v[2], v[3]); }
    }
    fft_fwd23(X);
    f32x2* Gk = rnd ? G2 : G1;
#pragma unroll 1
    for (int q = 0; q < 2; ++q) { const int id = otid() + 512 * q; f32x2 v[16];
#pragma unroll
      for (int k = 0; k < 16; ++k) v[k] = X[fpad(id * 16 + k)];
      dft16<false>(v);
#pragma unroll
      for (int k = 0; k < 16; k += 2) { f32x2 a = v[OIDX(k)] * (1.f / 32768.f), b = v[OIDX(k + 1)] * (1.f / 32768.f); *(f32x4*)(Gk + id * 16 + k) = (f32x4){a.x, a.y, b.x, b.y}; } }
    __syncthreads();
  }
#pragma unroll 1
  for (int rnd = 0; rnd < 2; ++rnd) {
#pragma unroll 1
    for (int q0 = 0; q0 < 8; q0 += 4) {
      const int tid = otid();
      f32x2 z[4][4];
#pragma unroll
      for (int qq = 0; qq < 4; ++qq)
#pragma unroll
        for (int jx = 0; jx < 4; ++jx) { const int n = tid + 512 * (q0 + qq) + 4096 * jx; z[qq][jx] = (f32x2){zc0[n], zc1[n]}; }
#pragma unroll
      for (int qq = 0; qq < 4; ++qq) { const int n0 = tid + 512 * (q0 + qq);
        if (rnd) { const f32x2 w0 = twid((float)n0 * (1.f / 32768.f));
          const f32x2 w1 = cmul(w0, (f32x2){R2, -R2}), w2 = (f32x2){w0.y, -w0.x}, w3 = cmul(w0, (f32x2){-R2, -R2});
          z[qq][0] = cmul(z[qq][0], w0); z[qq][1] = cmul(z[qq][1], w1); z[qq][2] = cmul(z[qq][2], w2); z[qq][3] = cmul(z[qq][3], w3); }
        f1_store(X, n0, z[qq][0], z[qq][1], z[qq][2], z[qq][3]); }
    }
    fft_fwd23(X);
    const f32x2* Gk = rnd ? G2 : G1;
#pragma unroll 1
    for (int q = 0; q < 2; ++q) { const int id = otid() + 512 * q; f32x2 v[16], w[16];
      f32x4 kk[8];
#pragma unroll
      for (int k = 0; k < 8; ++k) kk[k] = *(const f32x4*)(Gk + id * 16 + 2 * k);
#pragma unroll
      for (int k = 0; k < 16; ++k) v[k] = X[fpad(id * 16 + k)];
      dft16<false>(v);
#pragma unroll
      for (int k = 0; k < 16; k += 2) { w[k] = cmul(v[OIDX(k)], (f32x2){kk[k >> 1].x, kk[k >> 1].y}); w[k + 1] = cmul(v[OIDX(k + 1)], (f32x2){kk[k >> 1].z, kk[k >> 1].w}); }
      dft16<true>(w);
#pragma unroll
      for (int k = 0; k < 16; ++k) X[fpad(id * 16 + k)] = w[OIDX(k)]; }
    __syncthreads();
    { const int tid = otid();
#pragma unroll
    for (int q = 0; q < 2; ++q) pass16<true>(X, tid + 512 * q, 4); }
    __syncthreads();
    { const int tid = otid();
#pragma unroll
    for (int q = 0; q < 2; ++q) pass16<true>(X, tid + 512 * q, 8); }
    __syncthreads();
#pragma unroll 1
    for (int q0 = 0; q0 < 8; q0 += 4) {
      const int tid = otid();
      f32x2 r1[4][4], zz[4][4];
      if (rnd) {
#pragma unroll
        for (int qq = 0; qq < 4; ++qq)
#pragma unroll
          for (int jx = 0; jx < 4; ++jx) { const int n = tid + 512 * (q0 + qq) + 4096 * jx; r1[qq][jx] = G3[n]; zz[qq][jx] = (f32x2){zc0[n], zc1[n]}; }
      }
#pragma unroll
      for (int qq = 0; qq < 4; ++qq) { const int n0 = tid + 512 * (q0 + qq);
        const f32x2 t1 = twid((float)n0 * (1.f / 16384.f)), t2 = cmul(t1, t1), t3 = cmul(t2, t1);
        f32x2 v[4];
        v[0] = X[fpad(n0)]; v[1] = cmulc(X[fpad(4096 + n0)], t1); v[2] = cmulc(X[fpad(8192 + n0)], t2); v[3] = cmulc(X[fpad(12288 + n0)], t3);
        dft4<true>(v[0], v[1], v[2], v[3]);
        if (rnd == 0) {
#pragma unroll
          for (int jx = 0; jx < 4; ++jx) G3[n0 + 4096 * jx] = v[jx];
        } else { const f32x2 w0 = twid((float)n0 * (1.f / 32768.f));
          const f32x2 wj[4] = {w0, cmul(w0, (f32x2){R2, -R2}), (f32x2){w0.y, -w0.x}, cmul(w0, (f32x2){-R2, -R2})};
#pragma unroll
          for (int jx = 0; jx < 4; ++jx) { f32x2 y = r1[qq][jx] + cmulc(v[jx], wj[jx]) + zz[qq][jx] * skip; zc0[n0 + 4096 * jx] = y.x; zc1[n0 + 4096 * jx] = y.y; } } }
    }
    __syncthreads();
  }
}

DI bf16x8 pack8(const f32x16& x, int s) {
  u32x4 r; r.x = pk2(x[8 * s], x[8 * s + 1]); r.y = pk2(x[8 * s + 2], x[8 * s + 3]); r.z = pk2(x[8 * s + 4], x[8 * s + 5]); r.w = pk2(x[8 * s + 6], x[8 * s + 7]);
  return __builtin_bit_cast(bf16x8, r);
}
constexpr int SEGLEN = 17, NSEG = 16;
DI void scan_step_addr(const P& p, int b, int hd, int dir, int step, bool& isctx, int& n, size_t& unit) {
  isctx = step < 4;
  if (isctx) { n = dir ? 3 - step : step; unit = 2048 + (size_t)(b * 4 + n) * 4 + hd; }
  else { int m = step - 4; n = dir ? 255 - m : m; unit = (size_t)(b * 256 + n) * 4 + hd; }
}
DI void scan_decay(f32x16 (&S)[4], float d0, float d1, int h2) {
#pragma unroll
  for (int a = 0; a < 4; ++a)
#pragma unroll
    for (int i = 0; i < 16; ++i) { const int src = 32 * (a & 1) + (i & 3) + 8 * (i >> 2) + 4 * h2; S[a][i] *= __shfl((a < 2) ? d0 : d1, src, 64); }
}
template <int V> struct IC { static constexpr int value = V; };
template <bool OUT>
DI void scan_segment(const P& p, f32x16 (&S)[4], int b, int hd, int dir, int s0, int s1, float& dp0, float& dp1) {
  const int tid = threadIdx.x, wid = tid >> 6, lane = tid & 63, r = lane & 31, h2 = lane >> 5;
  const bf16_t* QI = (const bf16_t*)(p.ws + OFF_QI); const bf16_t* KST = (const bf16_t*)(p.ws + OFF_KST); const bf16_t* VT = (const bf16_t*)(p.ws + OFF_VT);
  const float* DD = (const float*)(p.ws + OFF_DD); bf16_t* OFB = (bf16_t*)(p.ws + OFF_OFB);
  char* img = g_smem;
  bf16x8 kq[2][2], kk[2][2], vb[2][4]; float d0[2], d1[2];
  auto fetch = [&](int step, auto PP, bool with_v) {
    constexpr int Q = decltype(PP)::value;
    bool isctx; int n; size_t unit; scan_step_addr(p, b, hd, dir, step, isctx, n, unit);
    const bf16_t* qi = QI + (unit * 2 + dir) * 8192; const bf16_t* kst = KST + (unit * 2 + dir) * 8192; const float* dd = DD + (unit * 2 + dir) * 128;
    const bf16_t* vt = VT + unit * 16384 + (size_t)(wid * 32) * 64;
#pragma unroll
    for (int e = 0; e < 2; ++e) { const int f = 2 * wid + e;
      if (OUT) { const int m = f >> 3, a = (f >> 1) & 3, s = f & 1; kq[Q][e] = *(const bf16x8*)(qi + (32 * m + r) * 128 + a * 32 + s * 16 + h2 * 8); }
      { const int s = f >> 2, a = f & 3; kk[Q][e] = *(const bf16x8*)(kst + (32 * a + r) * 64 + s * 16 + h2 * 8); } }
    if (with_v) {
#pragma unroll
      for (int s = 0; s < 4; ++s) vb[Q][s] = *(const bf16x8*)(vt + r * 64 + s * 16 + h2 * 8); }
    d0[Q] = dd[lane]; d1[Q] = dd[64 + lane];
  };
  auto fetch_v = [&](int step, auto PP) {
    constexpr int Q = decltype(PP)::value;
    bool isctx; int n; size_t unit; scan_step_addr(p, b, hd, dir, step, isctx, n, unit);
    const bf16_t* vt = VT + unit * 16384 + (size_t)(wid * 32) * 64;
#pragma unroll
    for (int s = 0; s < 4; ++s) vb[Q][s] = *(const bf16x8*)(vt + r * 64 + s * 16 + h2 * 8);
  };
  auto body = [&](int step, auto PP) {
    constexpr int Q = decltype(PP)::value;
    char* ib = img + Q * 32768;
#pragma unroll
    for (int e = 0; e < 2; ++e) { const int f = 2 * wid + e;
      if (OUT) *(bf16x8*)(ib + f * 1024 + lane * 16) = kq[Q][e];
      *(bf16x8*)(ib + (16 + f) * 1024 + lane * 16) = kk[Q][e]; }
    const float c0 = d0[Q], c1 = d1[Q];
    bool isctx; int n; size_t unit; scan_step_addr(p, b, hd, dir, step, isctx, n, unit);
    __syncthreads();
    fetch(min(step + 2, s1 - 1), PP, false);
    if (OUT && !isctx) {
      f32x16 o0, o1;
#pragma unroll
      for (int i = 0; i < 16; ++i) { o0[i] = 0.f; o1[i] = 0.f; }
#pragma unroll
      for (int a = 0; a < 4; ++a)
#pragma unroll
        for (int s = 0; s < 2; ++s) { bf16x8 sb = pack8(S[a], s);
          bf16x8 q0 = *(const bf16x8*)(ib + (a * 2 + s) * 1024 + lane * 16), q1 = *(const bf16x8*)(ib + (8 + a * 2 + s) * 1024 + lane * 16);
          o0 = MFMA32(q0, sb, o0); o1 = MFMA32(q1, sb, o1); }
      const int tl = otid(), ro = tl & 31, ho = (tl >> 5) & 1;
      bf16_t* ob = OFB + (size_t)dir * T * 1024 + ((size_t)b * 16384 + (size_t)n * 64 + 4 * ho) * 1024 + hd * 256 + wid * 32 + ro;
#pragma unroll
      for (int i = 0; i < 16; ++i) { const int row = (i & 3) + 8 * (i >> 2); ob[(size_t)row * 1024] = f2bf(o0[i]); ob[(size_t)(32 + row) * 1024] = f2bf(o1[i]); }
    }
    if (!OUT || step + 1 < s1) {
      scan_decay(S, c0, c1, h2);
      if (!OUT && wid == 0) { dp0 *= c0; dp1 *= c1; }
#pragma unroll
      for (int s = 0; s < 4; ++s)
#pragma unroll
        for (int a = 0; a < 4; ++a) { bf16x8 ka = *(const bf16x8*)(ib + (16 + s * 4 + a) * 1024 + lane * 16); S[a] = MFMA32(ka, vb[Q][s], S[a]); }
    }
    fetch_v(min(step + 2, s1 - 1), PP);
  };
  fetch(s0, IC<0>{}, true); fetch(min(s0 + 1, s1 - 1), IC<1>{}, true);
#pragma unroll 1
  for (int step = s0; step < s1; step += 2) {
    body(step, IC<0>{});
    if (step + 1 < s1) body(step + 1, IC<1>{});
  }
  __syncthreads();
}
DI void gla_scan_A(const P& p, int u) {
  const int tid = threadIdx.x, wid = tid >> 6, lane = tid & 63;
  const int chain = u >> 4, g = u & 15; if (g == NSEG - 1) return;
  const int b = chain >> 3, hd = (chain >> 1) & 3, dir = chain & 1;
  float* SLOC = (float*)(p.ws + OFF_SLOC); float* DSEG = (float*)(p.ws + OFF_DSEG);
  f32x16 S[4];
#pragma unroll
  for (int a = 0; a < 4; ++a)
#pragma unroll
    for (int i = 0; i < 16; ++i) S[a][i] = 0.f;
  float dp0 = 1.f, dp1 = 1.f;
  const int s0 = g * SEGLEN, s1 = min(s0 + SEGLEN, 260);
  scan_segment<false>(p, S, b, hd, dir, s0, s1, dp0, dp1);
  float* so = SLOC + ((size_t)u * 8 + wid) * 4096 + lane;
#pragma unroll
  for (int a = 0; a < 4; ++a)
#pragma unroll
    for (int i = 0; i < 16; ++i) so[(a * 16 + i) * 64] = S[a][i];
  if (wid == 0) { DSEG[(size_t)u * 128 + lane] = dp0; DSEG[(size_t)u * 128 + 64 + lane] = dp1; }
}
DI void gla_scan_C(const P& p, int u) {
  const int tid = threadIdx.x, wid = tid >> 6, lane = tid & 63, h2 = lane >> 5;
  const int chain = u >> 4, g = u & 15;
  const int b = chain >> 3, hd = (chain >> 1) & 3, dir = chain & 1;
  const float* SLOC = (const float*)(p.ws + OFF_SLOC); const float* DSEG = (const float*)(p.ws + OFF_DSEG);
  f32x16 S[4];
#pragma unroll
  for (int a = 0; a < 4; ++a)
#pragma unroll
    for (int i = 0; i < 16; ++i) S[a][i] = 0.f;
#pragma unroll 1
  for (int gp = 0; gp < g; ++gp) {
    const float* si = SLOC + ((size_t)(chain * 16 + gp) * 8 + wid) * 4096 + lane; const float* dg = DSEG + (size_t)(chain * 16 + gp) * 128;
    const float g0 = dg[lane], g1 = dg[64 + lane];
    float sv[32];
#pragma unroll
    for (int e = 0; e < 32; ++e) sv[e] = si[e * 64];
    scan_decay(S, g0, g1, h2);
#pragma unroll
    for (int hh = 0; hh < 2; ++hh) {
      if (hh) {
#pragma unroll
        for (int e = 0; e < 32; ++e) sv[e] = si[(32 + e) * 64]; }
#pragma unroll
      for (int e = 0; e < 32; ++e) S[hh * 2 + (e >> 4)][e & 15] += sv[e]; }
  }
  float dpa = 1.f, dpb = 1.f;
  const int s0 = g * SEGLEN, s1 = min(s0 + SEGLEN, 260);
  scan_segment<true>(p, S, b, hd, dir, s0, s1, dpa, dpb);
}

DI void phase_global_a(const P& p, int bid, int nb) {
  for (int u = bid; u < 256; u += nb) gla_scan_A(p, u);
  f32x2* G = (f32x2*)(p.ws + OFF_FFTS) + (size_t)bid * 3 * 16384;
  for (int c = bid; c < 1024; c += nb) fft_channel(p, c, G, G + 16384, G + 32768);
}
DI void phase_global_b(const P& p, int bid, int nb) {
  for (int u = bid; u < 256; u += nb) gla_scan_C(p, u);
  const int tid = threadIdx.x; (void)tid;
  bf16_t* W2 = (bf16_t*)(p.ws + OFF_W2);
#pragma unroll 1
  for (int job = 0; job < 6; ++job) {
    const float* src; int ld, K, ncols, dstld, drow0, mode; bf16_t* dst;
    switch (job) {
      case 0: src = p.p_gla; ld = 2048; K = 1024; ncols = 2048; dst = W2 + W2_PM / 2; dstld = 2048; drow0 = 0; mode = 0; break;
      case 1: src = p.p_hy; ld = 2048; K = 1024; ncols = 2048; dst = W2 + W2_PM / 2 + 1024; dstld = 2048; drow0 = 0; mode = 0; break;
      case 2: src = p.w_out; ld = 2048; K = 2048; ncols = 2048; dst = W2 + W2_WOUT / 2; dstld = 2048; drow0 = 0; mode = 0; break;
      case 3: src = p.ffn_gate; ld = 5632; K = 2048; ncols = 5632; dst = W2 + W2_WGU / 2; dstld = 2048; drow0 = 0; mode = 1; break;
      case 4: src = p.ffn_up; ld = 5632; K = 2048; ncols = 5632; dst = W2 + W2_WGU / 2; dstld = 2048; drow0 = 128; mode = 1; break;
      default: src = p.ffn_down; ld = 2048; K = 5632; ncols = 2048; dst = W2 + W2_WD / 2; dstld = 5632; drow0 = 0; mode = 0; break; }
    wconv(src, ld, K, 0, ncols, dst, dstld, drow0, mode, bid, nb);
  }
}

DI void phase_mergeprep(const P& p, int bid, int nb) {
  const int tid = threadIdx.x, wid = tid >> 6, lane = tid & 63;
  bf16_t* AM = (bf16_t*)(p.ws + OFF_AM);
  {
    const bf16_t* O = (const bf16_t*)(p.ws + OFF_O); const bf16_t* G = (const bf16_t*)(p.ws + OFF_G);
    for (int row = bid * 8 + wid; row < T; row += nb * 8) {
      const int c0 = lane * 16; const bf16_t* op = O + (size_t)row * 1024 + c0;
      f32x4 v[4]; float ss = 0.f;
      const bf16_t* ofp = (const bf16_t*)(p.ws + OFF_OFB) + (size_t)row * 1024 + c0; const bf16_t* obp = ofp + (size_t)T * 1024;
      u32x4 f0 = *(const u32x4*)ofp, f1 = *(const u32x4*)(ofp + 8), b0 = *(const u32x4*)obp, b1 = *(const u32x4*)(obp + 8);
      const u32x4 i0 = *(const u32x4*)op, i1 = *(const u32x4*)(op + 8);
#pragma unroll
      for (int q = 0; q < 4; ++q) { const unsigned ia = q < 2 ? i0[2 * (q & 1)] : i1[2 * (q & 1)], ib = q < 2 ? i0[2 * (q & 1) + 1] : i1[2 * (q & 1) + 1];
        v[q] = (f32x4){bflo(ia), bfhi(ia), bflo(ib), bfhi(ib)};
        const unsigned fa = q < 2 ? f0[2 * (q & 1)] : f1[2 * (q & 1)], fb = q < 2 ? f0[2 * (q & 1) + 1] : f1[2 * (q & 1) + 1];
        const unsigned ba = q < 2 ? b0[2 * (q & 1)] : b1[2 * (q & 1)], bb = q < 2 ? b0[2 * (q & 1) + 1] : b1[2 * (q & 1) + 1];
        v[q].x += bflo(fa) + bflo(ba); v[q].y += bfhi(fa) + bfhi(ba); v[q].z += bflo(fb) + bflo(bb); v[q].w += bfhi(fb) + bfhi(bb);
        ss += v[q].x * v[q].x + v[q].y * v[q].y + v[q].z * v[q].z + v[q].w * v[q].w; }
      ss += __shfl_xor(ss, 1, 64); ss += __shfl_xor(ss, 2, 64); ss += __shfl_xor(ss, 4, 64); ss += __shfl_xor(ss, 8, 64);
      const float rstd = rsqrtf(ss * (1.f / 256.f) + 1e-6f);
      const bf16_t* gp = G + (size_t)row * 1024 + c0; u32x4 g0 = *(const u32x4*)gp, g1 = *(const u32x4*)(gp + 8);
      const float* nw = p.gla_norm + (c0 & 255);
      float gv[16];
#pragma unroll
      for (int e = 0; e < 4; ++e) { gv[2 * e] = bflo(g0[e]); gv[2 * e + 1] = bfhi(g0[e]); gv[8 + 2 * e] = bflo(g1[e]); gv[8 + 2 * e + 1] = bfhi(g1[e]); }
      float y[16];
#pragma unroll
      for (int e = 0; e < 16; ++e) y[e] = v[e >> 2][e & 3] * rstd * nw[e] * gv[e];
      u32x4 w0, w1;
      w0.x = pk2(y[0], y[1]); w0.y = pk2(y[2], y[3]); w0.z = pk2(y[4], y[5]); w0.w = pk2(y[6], y[7]);
      w1.x = pk2(y[8], y[9]); w1.y = pk2(y[10], y[11]); w1.z = pk2(y[12], y[13]); w1.w = pk2(y[14], y[15]);
      bf16_t* ap = AM + (size_t)row * 2048 + c0; *(u32x4*)ap = w0; *(u32x4*)(ap + 8) = w1;
    }
  }
  {
    f32x2* tile = (f32x2*)g_smem;
    const bf16_t* ZH = (const bf16_t*)(p.ws + OFF_ZH); const float* ZC = (const float*)(p.ws + OFF_ZC);
    for (int it = bid; it < 4096; it += nb) {
      const int tr = it >> 4, ct = it & 15; const int t0 = tr * 64, c0 = ct * 64;
      { const int c = tid >> 3, t8 = (tid & 7) * 8; const float* s0 = ZC + (size_t)(c0 + c) * 16384 + t0 + t8; const float* s1 = s0 + (size_t)1024 * 16384;
        const f32x4 a0 = *(const f32x4*)s0, a1 = *(const f32x4*)(s0 + 4), b0 = *(const f32x4*)s1, b1 = *(const f32x4*)(s1 + 4);
#pragma unroll
        for (int e = 0; e < 4; ++e) { tile[c * 65 + t8 + e] = (f32x2){a0[e], b0[e]}; tile[c * 65 + t8 + 4 + e] = (f32x2){a1[e], b1[e]}; } }
      __syncthreads();
      const int t = tid >> 3, cg8 = (tid & 7) * 8;
#pragma unroll
      for (int b = 0; b < 2; ++b) {
        float x0[8];
#pragma unroll
        for (int e = 0; e < 8; ++e) x0[e] = p.short_b[c0 + cg8 + e];
#pragma unroll
        for (int tap = 0; tap < 3; ++tap) { const int tt = t + tap - 1; if (tt < 0 || tt > 63) continue;
          u32x4 a = *(const u32x4*)(ZH + ((size_t)b * 16384 + t0 + tt) * 1024 + c0 + cg8);
          const float* w0 = p.short_w + tap * 3072 + c0 + cg8;
#pragma unroll
          for (int e = 0; e < 4; ++e) { x0[2 * e] += bflo(a[e]) * w0[2 * e]; x0[2 * e + 1] += bfhi(a[e]) * w0[2 * e + 1]; } }
        float y[8];
#pragma unroll
        for (int e = 0; e < 8; ++e) { f32x2 yy = tile[(cg8 + e) * 65 + t]; y[e] = (b ? yy.y : yy.x) * x0[e]; }
        u32x4 w; w.x = pk2(y[0], y[1]); w.y = pk2(y[2], y[3]); w.z = pk2(y[4], y[5]); w.w = pk2(y[6], y[7]);
        *(u32x4*)(AM + ((size_t)b * 16384 + t0 + t) * 2048 + 1024 + c0 + cg8) = w;
      }
      __syncthreads();
    }
  }
}

struct MergeSched { const bf16_t* A; const bf16_t* Bt; int bid, nb;
  DI bool next(int i, Unit& u) const { const int L = (i >> 1) * nb + bid; const int part = i & 1; if (L >= 1024) return false; unit_order(L, 128, 8, u.pm, u.pn);
    u.a = (const char*)(A + (size_t)u.pm * 256 * 2048 + part * 1024); u.b = (const char*)(Bt + (size_t)u.pn * 256 * 2048 + part * 1024); u.tag = part; return true; } };
DI void phase_merge(const P& p, int bid, int nb) {
  const bf16_t* AM = (const bf16_t*)(p.ws + OFF_AM); const bf16_t* PM = (const bf16_t*)(p.ws + OFF_W2 + W2_PM);
  const bf16_t* MG = (const bf16_t*)p.out; bf16_t* MERGED = (bf16_t*)(p.ws + OFF_MERGED);
  MergeSched S{AM, PM, bid, nb};
  auto E = [&](f32x4 (&acc)[2][2][4][2], const Unit& u, int wr, int wc, int fr, int fq) {
    const int brow = u.pm * 256, bcol = u.pn * 256;
    if (u.tag == 0) {
#pragma unroll
      for (int ai = 0; ai < 2; ++ai)
#pragma unroll
        for (int m = 0; m < 4; ++m) { const bf16_t* rp = MG + (size_t)(brow + ai * 128 + wr * 64 + m * 16 + fr) * 4096 + bcol + wc * 32 + 8 * fq;
#pragma unroll
          for (int bj = 0; bj < 2; ++bj) { u32x4 ga = *(const u32x4*)(rp + bj * 128), gb = *(const u32x4*)(rp + 2048 + bj * 128);
#pragma unroll
            for (int e = 0; e < 4; ++e) { float r0 = (1.f + __expf(-bflo(gb[e]))) / (1.f + __expf(-bflo(ga[e]))), r1 = (1.f + __expf(-bfhi(gb[e]))) / (1.f + __expf(-bfhi(ga[e])));
              acc[ai][bj][m][e >> 1][(e & 1) * 2] *= r0; acc[ai][bj][m][e >> 1][(e & 1) * 2 + 1] *= r1; } } }
    } else {
#pragma unroll
      for (int ai = 0; ai < 2; ++ai)
#pragma unroll
        for (int m = 0; m < 4; ++m) { const size_t rowi = (size_t)(brow + ai * 128 + wr * 64 + m * 16 + fr); const bf16_t* rp = MG + rowi * 4096 + 2048 + bcol + wc * 32 + 8 * fq;
#pragma unroll
          for (int bj = 0; bj < 2; ++bj) { u32x4 gb = *(const u32x4*)(rp + bj * 128); float o[8];
#pragma unroll
            for (int e = 0; e < 4; ++e) { o[2 * e] = acc[ai][bj][m][e >> 1][(e & 1) * 2] * sigmoidf_(bflo(gb[e])); o[2 * e + 1] = acc[ai][bj][m][e >> 1][(e & 1) * 2 + 1] * sigmoidf_(bfhi(gb[e])); }
            u32x4 w; w.x = pk2(o[0], o[1]); w.y = pk2(o[2], o[3]); w.z = pk2(o[4], o[5]); w.w = pk2(o[6], o[7]);
            *(u32x4*)(MERGED + rowi * 2048 + bcol + bj * 128 + wc * 32 + 8 * fq) = w; } }
    }
  };
  gemm_stream(2048, 2048, 1024, S, E);
}

DI void phase_wout(const P& p, int bid, int nb) {
  const bf16_t* MERGED = (const bf16_t*)(p.ws + OFF_MERGED); const bf16_t* WO = (const bf16_t*)(p.ws + OFF_W2 + W2_WOUT); bf16_t* MIX = (bf16_t*)(p.ws + OFF_MIX);
  GridSched S{MERGED, WO, 2048, 2048, 128, 8, bid, nb};
  auto E = [&](f32x4 (&acc)[2][2][4][2], const Unit& u, int wr, int wc, int fr, int fq) { store_tile_bf16<0>(acc, MIX, 2048, u.pm * 256, u.pn * 256, 1.f, wr, wc, fr, fq); };
  gemm_stream(2048, 2048, 2048, S, E);
}

DI void phase_rowmid(const P& p, int bid, int nb) {
  const int tid = threadIdx.x, wid = tid >> 6, lane = tid & 63;
  const float* MOD = (const float*)(p.ws + OFF_MOD); const bf16_t* MIX = (const bf16_t*)(p.ws + OFF_MIX); bf16_t* HX2 = (bf16_t*)(p.ws + OFF_HX2); bf16_t* X1B = (bf16_t*)(p.ws + OFF_MIX);
  for (int row = bid * 8 + wid; row < T; row += nb * 8) {
    const float* md = MOD + (row >> 14) * 12288;
    float mv[32]; float ss = 0.f;
#pragma unroll
    for (int q = 0; q < 4; ++q) { u32x4 a = *(const u32x4*)(MIX + (size_t)row * 2048 + q * 512 + lane * 8);
#pragma unroll
      for (int e = 0; e < 4; ++e) { mv[q * 8 + 2 * e] = bflo(a[e]); mv[q * 8 + 2 * e + 1] = bfhi(a[e]); } }
#pragma unroll
    for (int e = 0; e < 32; ++e) ss += mv[e] * mv[e];
    ss = wave_sum(ss); const float rstd = rsqrtf(ss * (1.f / 2048.f) + 1e-6f);
    float ss2 = 0.f;
#pragma unroll
    for (int q = 0; q < 4; ++q)
#pragma unroll
      for (int hh = 0; hh < 2; ++hh) { const int idx = q * 512 + lane * 8 + hh * 4;
        f32x4 xv = *(const f32x4*)(p.x + (size_t)row * 2048 + idx), w = *(const f32x4*)(p.n_post_mix + idx), g1 = *(const f32x4*)(md + 4096 + idx);
#pragma unroll
        for (int e = 0; e < 4; ++e) { float x1 = xv[e] + g1[e] * (mv[q * 8 + hh * 4 + e] * rstd * w[e]); mv[q * 8 + hh * 4 + e] = x1; ss2 += x1 * x1; } }
    ss2 = wave_sum(ss2); const float rstd2 = rsqrtf(ss2 * (1.f / 2048.f) + 1e-6f);
#pragma unroll
    for (int q = 0; q < 4; ++q) { const int idx = q * 512 + lane * 8; float y[8];
#pragma unroll
      for (int hh = 0; hh < 2; ++hh) { f32x4 w = *(const f32x4*)(p.n_pre_ffn + idx + hh * 4), s2 = *(const f32x4*)(md + 8192 + idx + hh * 4), h2 = *(const f32x4*)(md + 6144 + idx + hh * 4);
#pragma unroll
        for (int e = 0; e < 4; ++e) y[hh * 4 + e] = mv[q * 8 + hh * 4 + e] * rstd2 * w[e] * (1.f + s2[e]) + h2[e]; }
      u32x4 o; o.x = pk2(y[0], y[1]); o.y = pk2(y[2], y[3]); o.z = pk2(y[4], y[5]); o.w = pk2(y[6], y[7]);
      *(u32x4*)(HX2 + (size_t)row * 2048 + idx) = o;
      u32x4 xo; xo.x = pk2(mv[q * 8], mv[q * 8 + 1]); xo.y = pk2(mv[q * 8 + 2], mv[q * 8 + 3]); xo.z = pk2(mv[q * 8 + 4], mv[q * 8 + 5]); xo.w = pk2(mv[q * 8 + 6], mv[q * 8 + 7]);
      *(u32x4*)(X1B + (size_t)row * 2048 + idx) = xo; }
  }
}

DI void phase_ffn1(const P& p, int bid, int nb) {
  const bf16_t* HX2 = (const bf16_t*)(p.ws + OFF_HX2); const bf16_t* WGU = (const bf16_t*)(p.ws + OFF_W2 + W2_WGU); bf16_t* HID = (bf16_t*)(p.ws + OFF_HID);
  GridSched S{HX2, WGU, 2048, 2048, 128, 44, bid, nb};
  auto E = [&](f32x4 (&acc)[2][2][4][2], const Unit& u, int wr, int wc, int fr, int fq) {
#pragma unroll
    for (int ai = 0; ai < 2; ++ai)
#pragma unroll
      for (int m = 0; m < 4; ++m) { float o[8];
#pragma unroll
        for (int n = 0; n < 2; ++n)
#pragma unroll
          for (int jx = 0; jx < 4; ++jx) { float gte = acc[ai][0][m][n][jx], up = acc[ai][1][m][n][jx]; o[n * 4 + jx] = gte * sigmoidf_(gte) * up; }
        u32x4 w; w.x = pk2(o[0], o[1]); w.y = pk2(o[2], o[3]); w.z = pk2(o[4], o[5]); w.w = pk2(o[6], o[7]);
        *(u32x4*)(HID + (size_t)(u.pm * 256 + ai * 128 + wr * 64 + m * 16 + fr) * 5632 + u.pn * 128 + wc * 32 + 8 * fq) = w; }
  };
  gemm_stream(2048, 2048, 2048, S, E);
}
DI void phase_ffn2(const P& p, int bid, int nb) {
  const bf16_t* HID = (const bf16_t*)(p.ws + OFF_HID); const bf16_t* WD = (const bf16_t*)(p.ws + OFF_W2 + W2_WD); bf16_t* FFN = (bf16_t*)(p.ws + OFF_FFN);
  GridSched S{HID, WD, 5632, 5632, 128, 8, bid, nb};
  auto E = [&](f32x4 (&acc)[2][2][4][2], const Unit& u, int wr, int wc, int fr, int fq) { store_tile_bf16<0>(acc, FFN, 2048, u.pm * 256, u.pn * 256, 1.f, wr, wc, fr, fq); };
  gemm_stream(5632, 5632, 5632, S, E);
}
DI void phase_final(const P& p, int bid, int nb) {
  const int tid = threadIdx.x, wid = tid >> 6, lane = tid & 63;
  const float* MOD = (const float*)(p.ws + OFF_MOD); const bf16_t* FFN = (const bf16_t*)(p.ws + OFF_FFN); const bf16_t* X1B = (const bf16_t*)(p.ws + OFF_MIX);
  for (int row = bid * 8 + wid; row < T; row += nb * 8) {
    const float* md = MOD + (row >> 14) * 12288;
    float mv[32]; float ss = 0.f;
#pragma unroll
    for (int q = 0; q < 4; ++q) { u32x4 a = *(const u32x4*)(FFN + (size_t)row * 2048 + q * 512 + lane * 8);
#pragma unroll
      for (int e = 0; e < 4; ++e) { mv[q * 8 + 2 * e] = bflo(a[e]); mv[q * 8 + 2 * e + 1] = bfhi(a[e]); } }
#pragma unroll
    for (int e = 0; e < 32; ++e) ss += mv[e] * mv[e];
    ss = wave_sum(ss); const float rstd = rsqrtf(ss * (1.f / 2048.f) + 1e-6f);
#pragma unroll
    for (int q = 0; q < 4; ++q)
#pragma unroll
      for (int hh = 0; hh < 2; ++hh) { const int idx = q * 512 + lane * 8 + hh * 4;
        const u32x2 xb = *(const u32x2*)(X1B + (size_t)row * 2048 + idx);
        f32x4 xv = {bflo(xb.x), bfhi(xb.x), bflo(xb.y), bfhi(xb.y)}, w = *(const f32x4*)(p.n_post_ffn + idx), g2 = *(const f32x4*)(md + 10240 + idx);
#pragma unroll
        for (int e = 0; e < 4; ++e) xv[e] += g2[e] * (mv[q * 8 + hh * 4 + e] * rstd * w[e]);
        *(f32x4*)(p.out + (size_t)row * 2048 + idx) = xv; }
  }
}

constexpr int NPHASE = 13;
#define RUN_PH(k, call) do { if (ph_lo <= (k) && (k) < ph_hi) { if ((k) > ph_lo) grid.sync(); call; } } while (0)
__global__ void __launch_bounds__(NTHREADS) hybrid_layer_kernel(P p, int ph_lo, int ph_hi) {
  cg::grid_group grid = cg::this_grid();
  const int bid = blockIdx.x, nb = gridDim.x;
  RUN_PH(0, phase_prep(p, bid, nb));
  RUN_PH(1, phase_pre(p, bid, nb));
  RUN_PH(2, phase_gemm1(p, bid, nb));
  RUN_PH(3, phase_local(p, bid, nb));
  RUN_PH(4, phase_global_a(p, bid, nb));
  RUN_PH(5, phase_global_b(p, bid, nb));
  RUN_PH(6, phase_mergeprep(p, bid, nb));
  RUN_PH(7, phase_merge(p, bid, nb));
  RUN_PH(8, phase_wout(p, bid, nb));
  RUN_PH(9, phase_rowmid(p, bid, nb));
  RUN_PH(10, phase_ffn1(p, bid, nb));
  RUN_PH(11, phase_ffn2(p, bid, nb));
  RUN_PH(12, phase_final(p, bid, nb));
}

extern "C" void kernel_launch(void* const* d_in, const int* in_sizes, int n_in, void* d_out, int out_size, void* d_ws, size_t ws_size, hipStream_t stream) {
  (void)in_sizes; (void)n_in; (void)out_size;
  if (ws_size < WS_NEEDED) { fprintf(stderr, "workspace too small: %zu < %zu\n", ws_size, (size_t)WS_NEEDED); return; }
  P p{};
  const float** f = (const float**)&p;
  for (int i = 0; i < 31; ++i) f[i] = (const float*)d_in[i];
  p.out = (float*)d_out; p.ws = (char*)d_ws;
  static int grid_blocks = 0;
  if (!grid_blocks) {
    hipFuncSetAttribute((const void*)hybrid_layer_kernel, hipFuncAttributeMaxDynamicSharedMemorySize, SMEM_BYTES);
    int dev = 0, cus = 0, per_cu = 0;
    hipGetDevice(&dev);
    hipDeviceGetAttribute(&cus, hipDeviceAttributeMultiprocessorCount, dev);
    hipOccupancyMaxActiveBlocksPerMultiprocessor(&per_cu, hybrid_layer_kernel, NTHREADS, SMEM_BYTES);
    if (per_cu < 1) per_cu = 1;
    grid_blocks = cus * 1;
  }
#if SINGLE_LAUNCH
  int lo = 0, hi = NPHASE;
  void* args[] = {&p, &lo, &hi};
  hipError_t e = hipLaunchCooperativeKernel((void*)hybrid_layer_kernel, dim3(grid_blocks), dim3(NTHREADS), args, SMEM_BYTES, stream);
  if (e != hipSuccess) fprintf(stderr, "cooperative launch failed: %s (grid %d)\n", hipGetErrorString(e), grid_blocks);
#else
  for (int ph = 0; ph < NPHASE; ++ph) hybrid_layer_kernel<<<grid_blocks, NTHREADS, SMEM_BYTES, stream>>>(p, ph, ph + 1);
#endif
}
```

```cpp
#include <hip/hip_runtime.h>
#include <hip/hip_cooperative_groups.h>
#include <cstdio>
namespace cg = cooperative_groups;

#ifndef SINGLE_LAUNCH
#define SINGLE_LAUNCH 1
#endif

#define DI __device__ __forceinline__
#define LAS __attribute__((address_space(3)))
typedef unsigned short bf16_t;
typedef short bf16x8 __attribute__((ext_vector_type(8)));
typedef float f32x2 __attribute__((ext_vector_type(2)));
typedef float f32x4 __attribute__((ext_vector_type(4)));
typedef float f32x16 __attribute__((ext_vector_type(16)));
typedef unsigned u32x2 __attribute__((ext_vector_type(2)));
typedef unsigned u32x4 __attribute__((ext_vector_type(4)));
typedef __bf16 bfv2 __attribute__((ext_vector_type(2)));

constexpr int T = 32768, TC = 33280, SEQ = 16384, D = 2048;
constexpr size_t MiB = 1048576;
constexpr int SMEM_BYTES = 147456;
constexpr int NTHREADS = 512;

constexpr size_t OFF_MOD = 0, OFF_HDN = 1 * MiB, OFF_LR = 4 * MiB, OFF_DD = 10 * MiB;
constexpr size_t OFF_HX = 16 * MiB, OFF_WIN = 146 * MiB, OFF_HT = 187 * MiB, OFF_QKV = 315 * MiB, OFF_G = 445 * MiB, OFF_ZH = 509 * MiB;
constexpr size_t OFF_O = 701 * MiB, OFF_ZC = 829 * MiB, OFF_VT = 957 * MiB, OFF_QI = 16 * MiB, OFF_KST = 81 * MiB;
constexpr size_t OFF_FFTS = 315 * MiB, OFF_AM = 16 * MiB, OFF_W2 = 315 * MiB, OFF_MERGED = 187 * MiB, OFF_MIX = 445 * MiB;
constexpr size_t OFF_HX2 = 187 * MiB, OFF_HID = 573 * MiB, OFF_FFN = 16 * MiB;
constexpr size_t OFF_SLOC = 146 * MiB, OFF_DSEG = 180 * MiB;
constexpr size_t OFF_OFB = 187 * MiB;
constexpr size_t WS_NEEDED = 1022 * MiB;
constexpr size_t W2_PM = 0, W2_WOUT = 8388608, W2_WGU = 16777216, W2_WD = 16777216 + 46137344;

struct P {
  const float *x, *c, *ctx, *c_ctx, *w_ada, *b_ada, *n_pre_mix, *n_post_mix, *n_pre_ffn, *n_post_ffn, *w_in;
  const float *wg_f, *bg_f, *wg_b, *bg_b, *gla_norm, *short_w, *short_b, *emb_w, *emb_b, *mlp_w, *mlp_b, *freq, *out_w, *skip;
  const float *p_gla, *p_hy, *w_out, *ffn_gate, *ffn_up, *ffn_down;
  float* out; char* ws;
};

extern __shared__ __attribute__((aligned(16))) char g_smem[];

DI unsigned pk2(float lo, float hi) { f32x2 v = {lo, hi}; bfv2 r = __builtin_convertvector(v, bfv2); return __builtin_bit_cast(unsigned, r); }
DI bf16_t f2bf(float f) { __bf16 h = (__bf16)f; return __builtin_bit_cast(bf16_t, h); }
DI float bf2f(bf16_t h) { return __uint_as_float(((unsigned)h) << 16); }
DI float bflo(unsigned u) { return __uint_as_float(u << 16); }
DI float bfhi(unsigned u) { return __uint_as_float(u & 0xffff0000u); }
DI float wave_sum(float v) { for (int m = 32; m >= 1; m >>= 1) v += __shfl_xor(v, m, 64); return v; }
DI float sigmoidf_(float v) { return __builtin_amdgcn_rcpf(1.f + __expf(-v)); }
#define MFMA16(a, b, c) __builtin_amdgcn_mfma_f32_16x16x32_bf16((a), (b), (c), 0, 0, 0)
#define MFMA32(a, b, c) __builtin_amdgcn_mfma_f32_32x32x16_bf16((a), (b), (c), 0, 0, 0)

DI void wconv(const float* __restrict__ src, int ld, int K, int col0, int ncols, bf16_t* __restrict__ dst, int dstld, int drow0, int mode, int bid, int nb) {
  float* t = (float*)g_smem;
  const int tid = threadIdx.x;
  if ((ncols & 63) == 0) {
    const int ntn = ncols / 64, ntk = K / 64, nt = ntn * ntk;
    for (int it = bid; it < nt; it += nb) {
      const int tn = it % ntn, tk = it / ntn;
#pragma unroll
      for (int q = 0; q < 8; ++q) { int e = tid + 512 * q; int r = e >> 6, c = e & 63; t[r * 65 + c] = src[(size_t)(tk * 64 + r) * ld + col0 + tn * 64 + c]; }
      __syncthreads();
      { int n = tid >> 3, kk = (tid & 7) * 8; int cs = tn * 64 + n;
        int drow = mode == 0 ? drow0 + cs : ((cs >> 7) * 256 + drow0 + (cs & 127));
        u32x4 v; v.x = pk2(t[(kk) * 65 + n], t[(kk + 1) * 65 + n]); v.y = pk2(t[(kk + 2) * 65 + n], t[(kk + 3) * 65 + n]);
        v.z = pk2(t[(kk + 4) * 65 + n], t[(kk + 5) * 65 + n]); v.w = pk2(t[(kk + 6) * 65 + n], t[(kk + 7) * 65 + n]);
        *(u32x4*)(dst + (size_t)drow * dstld + tk * 64 + kk) = v; }
      __syncthreads();
    }
    return;
  }
  const int ntn = ncols / 32, ntk = K / 64, nt = ntn * ntk;
  for (int it = bid; it < nt; it += nb) {
    const int tn = it % ntn, tk = it / ntn;
#pragma unroll
    for (int q = 0; q < 4; ++q) { int e = tid + 512 * q; int r = e >> 5, c = e & 31; t[r * 33 + c] = src[(size_t)(tk * 64 + r) * ld + col0 + tn * 32 + c]; }
    __syncthreads();
    { int n = tid >> 4, kk = (tid & 15) * 4; int cs = tn * 32 + n;
      int drow = mode == 0 ? drow0 + cs : ((cs >> 7) * 256 + drow0 + (cs & 127));
      u32x2 v; v.x = pk2(t[(kk) * 33 + n], t[(kk + 1) * 33 + n]); v.y = pk2(t[(kk + 2) * 33 + n], t[(kk + 3) * 33 + n]);
      *(u32x2*)(dst + (size_t)drow * dstld + tk * 64 + kk) = v; }
    __syncthreads();
  }
}

DI void phase_prep(const P& p, int bid, int nb) {
  const int tid = threadIdx.x;
  {
    float* sl = (float*)(g_smem + 16384); float* red = sl + 3 * 2048;
    float* MOD = (float*)(p.ws + OFF_MOD);
    for (int it = bid; it < 192; it += nb) {
      for (int e = tid; e < 3 * 2048; e += 512) { int r = e >> 11, k = e & 2047; float v = r < 2 ? p.c[r * 2048 + k] : p.c_ctx[k]; sl[e] = v / (1.f + __expf(-v)); }
      __syncthreads();
      const int cgp = tid & 15, kg = tid >> 4; const int n0 = it * 64 + cgp * 4;
      f32x4 a0 = {0, 0, 0, 0}, a1 = a0, a2 = a0;
#pragma unroll 8
      for (int kk = 0; kk < 64; ++kk) { int k = kg * 64 + kk; f32x4 w = *(const f32x4*)(p.w_ada + (size_t)k * 12288 + n0); a0 += w * sl[k]; a1 += w * sl[2048 + k]; a2 += w * sl[4096 + k]; }
      *(f32x4*)(red + (kg * 3 + 0) * 64 + cgp * 4) = a0; *(f32x4*)(red + (kg * 3 + 1) * 64 + cgp * 4) = a1; *(f32x4*)(red + (kg * 3 + 2) * 64 + cgp * 4) = a2;
      __syncthreads();
      if (tid < 192) { int r = tid >> 6, c = tid & 63; float s = p.b_ada[it * 64 + c];
#pragma unroll 8
        for (int k2 = 0; k2 < 32; ++k2) s += red[(k2 * 3 + r) * 64 + c]; MOD[r * 12288 + it * 64 + c] = s; }
      __syncthreads();
    }
  }
  {
    float* zb = (float*)(g_smem + 16384); float* ha = zb + 8 * 36; float* hb = ha + 8 * 64;
    bf16_t* HDN = (bf16_t*)(p.ws + OFF_HDN);
    const int tl = tid >> 6, j = tid & 63;
    for (int it = bid; it < 2048; it += nb) {
      const int t = it * 8 + tl;
      if (j < 33) { float v; if (j == 0) v = (float)t * (1.f / 16383.f); else { int i = (j - 1) & 15; float fr = 1e-4f + (float)i * ((15.f - 1e-4f) / 15.f); float turns = fr * ((float)t * (1.f / 16384.f)); turns -= floorf(turns);
          v = (j <= 16) ? __builtin_amdgcn_cosf(turns) : -__builtin_amdgcn_sinf(turns); } zb[tl * 36 + j] = v; }
      __syncthreads();
      float acc = p.emb_b[j];
#pragma unroll 3
      for (int i = 0; i < 33; ++i) acc += zb[tl * 36 + i] * p.emb_w[i * 64 + j];
      ha[tl * 64 + j] = __sinf(p.freq[j] * acc);
      __syncthreads();
      acc = p.mlp_b[j];
#pragma unroll 8
      for (int i = 0; i < 64; ++i) acc += ha[tl * 64 + i] * p.mlp_w[i * 64 + j];
      hb[tl * 64 + j] = __sinf(p.freq[64 + j] * acc);
      __syncthreads();
      acc = p.mlp_b[64 + j];
#pragma unroll 8
      for (int i = 0; i < 64; ++i) acc += hb[tl * 64 + i] * p.mlp_w[4096 + i * 64 + j];
      HDN[(size_t)t * 64 + j] = f2bf(__sinf(p.freq[128 + j] * acc));
      __syncthreads();
    }
  }
}

DI void phase_pre(const P& p, int bid, int nb) {
  const int tid = threadIdx.x, wid = tid >> 6, lane = tid & 63;
  const float* MOD = (const float*)(p.ws + OFF_MOD);
  bf16_t* HX = (bf16_t*)(p.ws + OFF_HX);
  for (int row = bid * 8 + wid; row < TC; row += nb * 8) {
    const float* src; int mrow;
    if (row < T) { src = p.x + (size_t)row * D; mrow = row >> 14; } else { src = p.ctx + (size_t)(row - T) * D; mrow = 2; }
    f32x4 v[8]; float ss = 0.f;
#pragma unroll
    for (int q = 0; q < 8; ++q) { v[q] = *(const f32x4*)(src + q * 256 + lane * 4); ss += v[q].x * v[q].x + v[q].y * v[q].y + v[q].z * v[q].z + v[q].w * v[q].w; }
    ss = wave_sum(ss); const float rstd = rsqrtf(ss * (1.f / 2048.f) + 1e-6f);
    const float* sh = MOD + mrow * 12288; const float* sc = sh + 2048;
#pragma unroll
    for (int q = 0; q < 8; ++q) { int idx = q * 256 + lane * 4; f32x4 w = *(const f32x4*)(p.n_pre_mix + idx), s1 = *(const f32x4*)(sc + idx), h1 = *(const f32x4*)(sh + idx);
      f32x4 y = v[q] * rstd * w * (1.f + s1) + h1; u32x2 o; o.x = pk2(y.x, y.y); o.y = pk2(y.z, y.w); *(u32x2*)(HX + (size_t)row * D + idx) = o; }
  }
  {
    const int fr = lane & 15, fq = lane >> 4;
    const bf16_t* HDN = (const bf16_t*)(p.ws + OFF_HDN); float* HT = (float*)(p.ws + OFF_HT);
    for (int id = bid * 8 + wid; id < 128 * 64; id += nb * 8) {
      const int mt = id & 127, ng = id >> 7; const int ch = mt * 16 + fr;
      bf16x8 a[2];
#pragma unroll
      for (int s = 0; s < 2; ++s)
#pragma unroll
        for (int i = 0; i < 8; ++i) a[s][i] = (short)f2bf(p.out_w[(size_t)(s * 32 + fq * 8 + i) * 2048 + ch]);
      const float lo = -120.39728043259361f, hi = 40.546510810816436f;
      const float delta = fabsf(lo + (float)(ch & 1023) * ((hi - lo) / 1023.f));
      for (int q = 0; q < 16; ++q) {
        const int n0 = (ng * 16 + q) * 16;
        bf16x8 b0 = *(const bf16x8*)(HDN + (size_t)(n0 + fr) * 64 + fq * 8), b1 = *(const bf16x8*)(HDN + (size_t)(n0 + fr) * 64 + 32 + fq * 8);
        f32x4 acc = {0, 0, 0, 0};
        acc = MFMA16(b0, a[0], acc); acc = MFMA16(b1, a[1], acc);
#pragma unroll
        for (int jj = 0; jj < 4; ++jj) { float tl = (float)(n0 + 4 * fq + jj) * (1.f / 16383.f); acc[jj] *= __expf(-tl * delta); }
        *(f32x4*)(HT + (size_t)ch * 16384 + n0 + 4 * fq) = acc;
      }
    }
  }
  bf16_t* WIN = (bf16_t*)(p.ws + OFF_WIN);
#pragma unroll 1
  for (int job = 0; job < 7; ++job) {
    int col0, ncols, drow0, mode = 0;
    switch (job) { case 0: col0 = 0; ncols = 2048; drow0 = 0; break; case 1: col0 = 2080; ncols = 1024; drow0 = 2048; break;
      case 2: col0 = 3104; ncols = 1024; drow0 = 3072; break;
      case 3: col0 = 4128; ncols = 1024; drow0 = 4096; mode = 1; break;
      case 4: col0 = 5152; ncols = 1024; drow0 = 4096 + 128; mode = 1; break;
      case 5: col0 = 6176; ncols = 4096; drow0 = 6144; break; default: col0 = 2048; ncols = 32; drow0 = 10240; break; }
    wconv(p.w_in, 10272, 2048, col0, ncols, WIN, 2048, drow0, mode, bid, nb);
  }
  for (size_t e = (size_t)bid * 512 + tid; e < (size_t)224 * 2048 / 8; e += (size_t)nb * 512) ((u32x4*)(WIN + (size_t)10272 * 2048))[e] = (u32x4){0u, 0u, 0u, 0u};
}

DI int lds_byte(int r, int c) { int st = (r >> 4) * 2 + (c >> 5), rr = r & 15, cc = c & 31, ob = rr * 64 + cc * 2; return st * 1024 + (ob ^ (((ob >> 9) & 1) << 5)); }
DI void stage_rc(int b, int& R, int& C) { int st = b / 1024, sb = b % 1024, swz = sb ^ (((sb >> 9) & 1) << 5); R = (st >> 1) * 16 + swz / 64; C = (st & 1) * 32 + (swz % 64) / 2; }
DI int perm32(int rho) { const int n = rho >> 4, i = rho & 15; return 8 * (i >> 2) + 4 * n + (i & 3); }
DI void unit_order(int L, int nM, int nN, int& pm, int& pn) {
  const int nwg = nM * nN; int wgid = L;
  { const int q = nwg / 8, r = nwg % 8, xcd = wgid % 8, off = wgid / 8; wgid = (xcd < r ? xcd * (q + 1) : r * (q + 1) + (xcd - r) * q) + off; }
  const int nig = 8 * nN, gid = wgid / nig, fm = gid * 8, gsz = (nM - fm) < 8 ? (nM - fm) : 8;
  pm = fm + ((wgid % nig) % gsz); pn = (wgid % nig) / gsz;
}

struct Unit { const char* a; const char* b; int pm, pn, tag; };
template <class Sched, class Epi>
DI void gemm_stream(const long lda, const long ldb, const int K, const Sched& S, const Epi& E) {
  LAS unsigned char* lds = (LAS unsigned char*)g_smem;
  constexpr int HTB = 128 * 64 * 2;
  const int tid = threadIdx.x, wid = __builtin_amdgcn_readfirstlane(tid >> 6), lane = tid & 63, wr = wid >> 2, wc = wid & 3, fr = lane & 15, fq = lane >> 4;
  const int nt = K / 64;
  unsigned voffA[2], voffB[2];
#pragma unroll
  for (int i = 0; i < 2; ++i) { int R, C; stage_rc(tid * 16 + i * 8192, R, C); const int Rb = (R & ~31) + perm32(R & 31);
    voffA[i] = (unsigned)(R * (int)lda + C) * 2u; voffB[i] = (unsigned)(Rb * (int)ldb + C) * 2u; }
  const size_t kstep = 128, hstepA = (size_t)128 * lda * 2, hstepB = (size_t)128 * ldb * 2;
  const unsigned ldsw = (unsigned)wid * 1024u;
  const int aoff = lds_byte(wr * 64 + fr, fq * 8), boff = lds_byte(wc * 32 + fr, fq * 8);
#define G_SA(b, h) (((b) * 2 + (h)) * HTB)
#define G_SB(b, h) ((4 + (b) * 2 + (h)) * HTB)
#define G_STAGE(bufoff, gbase, voff) do { _Pragma("unroll") for (int _i = 0; _i < 2; ++_i) \
    __builtin_amdgcn_global_load_lds((const unsigned*)((const char*)(gbase) + (voff)[_i]), (LAS unsigned*)(lds + (bufoff) + ldsw + _i * 8192), 16, 0, 0); } while (0)
#define G_LDA(dst, b, h) do { _Pragma("unroll") for (int m = 0; m < 4; ++m) _Pragma("unroll") for (int k = 0; k < 2; ++k) dst[m][k] = *(const LAS bf16x8*)(lds + G_SA(b, h) + aoff + m * 2048 + k * 1024); } while (0)
#define G_LDB(dst, b, h) do { _Pragma("unroll") for (int n = 0; n < 2; ++n) _Pragma("unroll") for (int k = 0; k < 2; ++k) dst[n][k] = *(const LAS bf16x8*)(lds + G_SB(b, h) + boff + n * 2048 + k * 1024); } while (0)
#define G_MMA(ai, bj, At_, Bt_) do { __builtin_amdgcn_s_setprio(1); _Pragma("unroll") for (int m = 0; m < 4; ++m) _Pragma("unroll") for (int n = 0; n < 2; ++n) _Pragma("unroll") for (int k = 0; k < 2; ++k) \
    acc[ai][bj][m][n] = MFMA16(Bt_[n][k], At_[m][k], acc[ai][bj][m][n]); __builtin_amdgcn_s_setprio(0); } while (0)
#define G_WAIT_V(n) asm volatile("s_waitcnt vmcnt(" #n ")" ::: "memory")
#define G_WAIT_L(n) asm volatile("s_waitcnt lgkmcnt(" #n ")" ::: "memory")
#define G_BAR __builtin_amdgcn_s_barrier()
#define G_SCHED __builtin_amdgcn_sched_barrier(0)
  Unit cur, nxt; int ui = 0;
  if (!S.next(0, cur)) return;
  f32x4 acc[2][2][4][2];
#pragma unroll
  for (int a = 0; a < 2; ++a)
#pragma unroll
    for (int b = 0; b < 2; ++b)
#pragma unroll
      for (int m = 0; m < 4; ++m)
#pragma unroll
        for (int n = 0; n < 2; ++n) acc[a][b][m][n] = (f32x4){0.f, 0.f, 0.f, 0.f};
  bf16x8 At[4][2], B0[2][2], B1[2][2];
  const char* cA = cur.a; const char* cB = cur.b;
  G_WAIT_V(0);
  G_STAGE(G_SB(0, 0), cB, voffB); G_STAGE(G_SA(0, 0), cA, voffA); G_STAGE(G_SB(0, 1), cB + hstepB, voffB); G_STAGE(G_SA(0, 1), cA + hstepA, voffA);
  if (wr == 1) G_BAR;
  G_WAIT_V(4); G_BAR;
  G_STAGE(G_SB(1, 0), cB + kstep, voffB); G_STAGE(G_SA(1, 0), cA + kstep, voffA); G_STAGE(G_SB(1, 1), cB + hstepB + kstep, voffB);
  G_WAIT_V(6); G_BAR;
  for (;;) {
    const bool has_next = S.next(ui + 1, nxt);
    const char* nA = has_next ? nxt.a : cA; const char* nB = has_next ? nxt.b : cB;
#pragma unroll 1
    for (int t = 0; t < nt; t += 2) {
      const bool last = (t == nt - 2);
      const char* a1 = cA + (size_t)(t + 1) * kstep;
      const char* a2 = last ? nA : cA + (size_t)(t + 2) * kstep; const char* b2 = last ? nB : cB + (size_t)(t + 2) * kstep;
      const char* a3 = a2 + kstep; const char* b3 = b2 + kstep;
      G_LDB(B0, 0, 0); G_SCHED; G_LDA(At, 0, 0); G_STAGE(G_SA(1, 1), a1 + hstepA, voffA);
      G_WAIT_L(8); G_BAR; G_WAIT_L(0); G_MMA(0, 0, At, B0); G_BAR; G_SCHED;
      G_LDB(B1, 0, 1); G_STAGE(G_SB(0, 0), b2, voffB);
      G_BAR; G_WAIT_L(0); G_MMA(0, 1, At, B1); G_BAR;
      G_LDA(At, 0, 1); G_STAGE(G_SA(0, 0), a2, voffA);
      G_BAR; G_WAIT_L(0); G_MMA(1, 0, At, B0); G_BAR; G_SCHED;
      G_STAGE(G_SB(0, 1), b2 + hstepB, voffB);
      G_WAIT_V(6); G_BAR; G_MMA(1, 1, At, B1); G_BAR;
      G_LDB(B0, 1, 0); G_SCHED; G_LDA(At, 1, 0); G_STAGE(G_SA(0, 1), a2 + hstepA, voffA);
      G_WAIT_L(8); G_BAR; G_WAIT_L(0); G_MMA(0, 0, At, B0); G_BAR; G_SCHED;
      G_LDB(B1, 1, 1); G_STAGE(G_SB(1, 0), b3, voffB);
      G_BAR; G_WAIT_L(0); G_MMA(0, 1, At, B1); G_BAR;
      G_LDA(At, 1, 1); G_STAGE(G_SA(1, 0), a3, voffA);
      G_BAR; G_WAIT_L(0); G_MMA(1, 0, At, B0); G_BAR; G_SCHED;
      G_STAGE(G_SB(1, 1), b3 + hstepB, voffB);
      G_WAIT_V(6); G_BAR; G_MMA(1, 1, At, B1); G_BAR;
    }
    E(acc, cur, wr, wc, fr, fq);
    if (!has_next) break;
    if (!(nxt.tag & 1)) {
#pragma unroll
      for (int a = 0; a < 2; ++a)
#pragma unroll
        for (int b = 0; b < 2; ++b)
#pragma unroll
          for (int m = 0; m < 4; ++m)
#pragma unroll
            for (int n = 0; n < 2; ++n) acc[a][b][m][n] = (f32x4){0.f, 0.f, 0.f, 0.f};
    }
    cur = nxt; cA = nA; cB = nB; ++ui;
  }
  G_WAIT_V(0);
  if (wr == 0) G_BAR;
  G_BAR;
}

struct GridSched {
  const bf16_t* A; const bf16_t* Bt; long lda, ldb; int nM, nN, bid, nb;
  DI bool next(int i, Unit& u) const { const int L = i * nb + bid; if (L >= nM * nN) return false; unit_order(L, nM, nN, u.pm, u.pn);
    u.a = (const char*)(A + (size_t)u.pm * 256 * lda); u.b = (const char*)(Bt + (size_t)u.pn * 256 * ldb); u.tag = 0; return true; }
};

DI void zero_acc(f32x4 (&acc)[2][2][4][2]) {
#pragma unroll
  for (int a = 0; a < 2; ++a)
#pragma unroll
    for (int b = 0; b < 2; ++b)
#pragma unroll
      for (int m = 0; m < 4; ++m)
#pragma unroll
        for (int n = 0; n < 2; ++n) acc[a][b][m][n] = (f32x4){0.f, 0.f, 0.f, 0.f};
}

template <int ACT>
DI void store_tile_bf16(const f32x4 (&acc)[2][2][4][2], bf16_t* dst, long ld, int brow, int col0, float scale, int wr, int wc, int fr, int fq) {
#pragma unroll
  for (int ai = 0; ai < 2; ++ai)
#pragma unroll
    for (int m = 0; m < 4; ++m) {
      bf16_t* rp = dst + (long)(brow + ai * 128 + wr * 64 + m * 16 + fr) * ld + col0 + wc * 32 + 8 * fq;
#pragma unroll
      for (int bj = 0; bj < 2; ++bj) {
        f32x4 v0 = acc[ai][bj][m][0], v1 = acc[ai][bj][m][1];
        if (ACT == 1) { v0 *= scale; v1 *= scale; }
        if (ACT == 2) {
#pragma unroll
          for (int j = 0; j < 4; ++j) { v0[j] = v0[j] * sigmoidf_(v0[j]); v1[j] = v1[j] * sigmoidf_(v1[j]); } }
        u32x4 w; w.x = pk2(v0[0], v0[1]); w.y = pk2(v0[2], v0[3]); w.z = pk2(v1[0], v1[1]); w.w = pk2(v1[2], v1[3]);
        *(u32x4*)(rp + bj * 128) = w;
      }
    }
}

struct Gemm1Sched { const bf16_t* A; const bf16_t* Bt; int bid, nb;
  DI bool next(int i, Unit& u) const { const int L = i * nb + bid; const int nmain = 128 * 41; if (L >= nmain + 18) return false;
    if (L < nmain) unit_order(L, 128, 41, u.pm, u.pn); else { int e = L - nmain; u.pm = 128 + e / 9; int c = e % 9; u.pn = c < 8 ? c : 40; }
    u.a = (const char*)(A + (size_t)u.pm * 256 * 2048); u.b = (const char*)(Bt + (size_t)u.pn * 256 * 2048); u.tag = 0; return true; } };
DI void phase_gemm1(const P& p, int bid, int nb) {
  const bf16_t* HX = (const bf16_t*)(p.ws + OFF_HX); const bf16_t* WIN = (const bf16_t*)(p.ws + OFF_WIN);
  bf16_t* QKV = (bf16_t*)(p.ws + OFF_QKV); bf16_t* G = (bf16_t*)(p.ws + OFF_G); bf16_t* ZH = (bf16_t*)(p.ws + OFF_ZH); bf16_t* MG = (bf16_t*)p.out;
  float* LR = (float*)(p.ws + OFF_LR);
  Gemm1Sched S{HX, WIN, bid, nb};
  auto E = [&](f32x4 (&acc)[2][2][4][2], const Unit& u, int wr, int wc, int fr, int fq) {
    const int brow = u.pm * 256, pn = u.pn;
    if (pn < 2) store_tile_bf16<1>(acc, QKV, 2048, brow, pn * 256, 0.08838834764831845f, wr, wc, fr, fq);
    else if (pn < 8) store_tile_bf16<0>(acc, QKV, 2048, brow, pn * 256, 1.f, wr, wc, fr, fq);
    else if (pn < 12) store_tile_bf16<2>(acc, G, 1024, brow, (pn - 8) * 256, 1.f, wr, wc, fr, fq);
    else if (pn < 16) store_tile_bf16<0>(acc, ZH, 1024, brow, (pn - 12) * 256, 1.f, wr, wc, fr, fq);
    else if (pn < 24) {
      const int lane = threadIdx.x & 63; const int cb = (pn - 16) * 128 + wc * 32 + 8 * fq;
      const int upsrc = (lane & ~15) | ((fr - 1) & 15), dnsrc = (lane & ~15) | ((fr + 1) & 15);
      float* ZCf = (float*)(p.ws + OFF_ZC);
#pragma unroll
      for (int n = 0; n < 2; ++n)
#pragma unroll
        for (int jj = 0; jj < 4; ++jj) { const int c = cb + 4 * n + jj;
          const float a0 = p.short_w[1024 + c], a1 = p.short_w[3072 + 1024 + c], a2 = p.short_w[6144 + 1024 + c], ab = p.short_b[1024 + c];
          const float v0 = p.short_w[2048 + c], v1 = p.short_w[3072 + 2048 + c], v2 = p.short_w[6144 + 2048 + c], vbias = p.short_b[2048 + c];
#pragma unroll
          for (int ai = 0; ai < 2; ++ai) { const int t0 = brow + ai * 128 + wr * 64; const int bb = t0 >> 14, tin = t0 & 16383;
            float xr[4], vr[4], xu[4], vu[4], xd[4], vd[4];
#pragma unroll
            for (int m = 0; m < 4; ++m) { xr[m] = acc[ai][0][m][n][jj]; vr[m] = acc[ai][1][m][n][jj];
              xu[m] = __shfl(xr[m], upsrc, 64); vu[m] = __shfl(vr[m], upsrc, 64); xd[m] = __shfl(xr[m], dnsrc, 64); vd[m] = __shfl(vr[m], dnsrc, 64); }
            float* zp = ZCf + ((size_t)bb * 1024 + c) * 16384 + tin + fr;
#pragma unroll
            for (int m = 0; m < 4; ++m) {
              const float xup = fr > 0 ? xu[m] : (m > 0 ? xu[m - 1] : 0.f), vup = fr > 0 ? vu[m] : (m > 0 ? vu[m - 1] : 0.f);
              const float xdn = fr < 15 ? xd[m] : (m < 3 ? xd[m + 1] : 0.f), vdn = fr < 15 ? vd[m] : (m < 3 ? vd[m + 1] : 0.f);
              const float ux = a0 * xup + a1 * xr[m] + a2 * xdn + ab, uv = v0 * vup + v1 * vr[m] + v2 * vdn + vbias;
              zp[16 * m] = ux * uv; } } }
    }
    else if (pn < 40) store_tile_bf16<0>(acc, MG, 4096, brow, (pn - 24) * 256, 1.f, wr, wc, fr, fq);
    else if (wc == 0) {
#pragma unroll
      for (int ai = 0; ai < 2; ++ai)
#pragma unroll
        for (int m = 0; m < 4; ++m) { float* rp = LR + (size_t)(brow + ai * 128 + wr * 64 + m * 16 + fr) * 32 + 8 * fq;
          *(f32x4*)(rp) = acc[ai][0][m][0]; *(f32x4*)(rp + 4) = acc[ai][0][m][1]; }
    }
  };
  gemm_stream(2048, 2048, 2048, S, E);
}

DI void phase_local(const P& p, int bid, int nb) {
  const int tid = threadIdx.x, wid = tid >> 6, lane = tid & 63, fr = lane & 15, fq = lane >> 4;
  float* bL = (float*)g_smem;
  bf16_t* Qs = (bf16_t*)(g_smem + 33280);
  bf16_t* Ks = Qs + 64 * 136;
  bf16_t* KT = Ks + 64 * 136;
  bf16_t* Pm = KT + 128 * 72;
  bf16_t* VTl = Pm + 64 * 136;
  float* tot = (float*)(VTl + 256 * 72);
  float* wgL = (float*)KT;
  const bf16_t* QKV = (const bf16_t*)(p.ws + OFF_QKV); const float* LR = (const float*)(p.ws + OFF_LR);
  bf16_t* QI = (bf16_t*)(p.ws + OFF_QI); bf16_t* KST = (bf16_t*)(p.ws + OFF_KST); bf16_t* VT = (bf16_t*)(p.ws + OFF_VT);
  float* DD = (float*)(p.ws + OFF_DD); bf16_t* O = (bf16_t*)(p.ws + OFF_O);
  for (int u = bid; u < 2080; u += nb) {
    int b, n, hd; size_t row0; const bool isctx = u >= 2048;
    if (!isctx) { hd = u & 3; n = (u >> 2) & 255; b = u >> 10; row0 = (size_t)b * 16384 + n * 64; }
    else { int v = u - 2048; hd = v & 3; n = (v >> 2) & 3; b = v >> 4; row0 = (size_t)T + b * 256 + n * 64; }
    { const bf16_t* vp = QKV + (row0 + lane) * 2048 + 1024 + hd * 256 + wid * 32;
#pragma unroll
      for (int q = 0; q < 4; ++q) { bf16x8 v = *(const bf16x8*)(vp + q * 8);
#pragma unroll
        for (int e = 0; e < 8; ++e) VTl[(wid * 32 + q * 8 + e) * 72 + lane] = (bf16_t)v[e]; } }
    for (int dir = 0; dir < 2; ++dir) {
      { const float* wg = dir ? p.wg_b : p.wg_f; const float* bg = dir ? p.bg_b : p.bg_f;
        *(f32x4*)(wgL + (tid >> 5) * 128 + (tid & 31) * 4) = *(const f32x4*)(wg + (tid >> 5) * 512 + hd * 128 + (tid & 31) * 4);
        if (tid < 128) wgL[2048 + tid] = bg[hd * 128 + tid]; }
      __syncthreads();
      { const float* lr = LR + (row0 + lane) * 32 + dir * 16;
        f32x4 l0 = *(const f32x4*)(lr), l1 = *(const f32x4*)(lr + 4), l2 = *(const f32x4*)(lr + 8), l3 = *(const f32x4*)(lr + 12);
#pragma unroll 4
        for (int e = 0; e < 16; ++e) { const int dk = wid * 16 + e; float z = wgL[2048 + dk];
#pragma unroll
          for (int r = 0; r < 4; ++r) z += l0[r] * wgL[r * 128 + dk] + l1[r] * wgL[(4 + r) * 128 + dk] + l2[r] * wgL[(8 + r) * 128 + dk] + l3[r] * wgL[(12 + r) * 128 + dk];
          bL[lane * 129 + dk] = (fminf(z, 0.f) - __logf(1.f + __expf(-fabsf(z)))) * (1.f / 16.f); } }
      __syncthreads();
      { const int col = tid & 127, seg = tid >> 7; float a = 0.f;
#pragma unroll
        for (int i = 0; i < 16; ++i) { const int row = dir ? (seg * 16 + 15 - i) : (seg * 16 + i); a += bL[row * 129 + col]; bL[row * 129 + col] = a; }
        tot[seg * 128 + col] = a; }
      __syncthreads();
      { const int col = tid & 127, seg = tid >> 7; float off = 0.f;
#pragma unroll
        for (int s2 = 0; s2 < 4; ++s2) { const bool use = dir ? (s2 > seg) : (s2 < seg); if (use) off += tot[s2 * 128 + col]; }
#pragma unroll
        for (int i = 0; i < 16; ++i) bL[(seg * 16 + i) * 129 + col] += off; }
      __syncthreads();
      { const int j = lane;
        const bf16_t* qp = QKV + (row0 + j) * 2048 + hd * 128 + wid * 16; const bf16_t* kp = qp + 512;
        bf16x8 q0 = *(const bf16x8*)qp, q1 = *(const bf16x8*)(qp + 8), k0 = *(const bf16x8*)kp, k1 = *(const bf16x8*)(kp + 8);
        const int jref = dir ? 32 : 31, jlast = dir ? 0 : 63;
        float qiv[16], qsv[16], ksv[16];
#pragma unroll
        for (int e = 0; e < 16; ++e) { const int dk = wid * 16 + e; float bq = bL[j * 129 + dk], br = bL[jref * 129 + dk], bl = bL[jlast * 129 + dk];
          float qv = bf2f((bf16_t)(e < 8 ? q0[e & 7] : q1[e & 7])), kv = bf2f((bf16_t)(e < 8 ? k0[e & 7] : k1[e & 7]));
          qsv[e] = qv * __expf(bq - br); ksv[e] = kv * __expf(br - bq);
          qiv[e] = qv * __expf(bq); KT[dk * 72 + j] = f2bf(kv * __expf(bl - bq));
          if (j == jlast) DD[((size_t)u * 2 + dir) * 128 + dk] = __expf(bl); }
        u32x4 w0, w1;
        w0.x = pk2(qsv[0], qsv[1]); w0.y = pk2(qsv[2], qsv[3]); w0.z = pk2(qsv[4], qsv[5]); w0.w = pk2(qsv[6], qsv[7]);
        w1.x = pk2(qsv[8], qsv[9]); w1.y = pk2(qsv[10], qsv[11]); w1.z = pk2(qsv[12], qsv[13]); w1.w = pk2(qsv[14], qsv[15]);
        *(u32x4*)(Qs + j * 136 + wid * 16) = w0; *(u32x4*)(Qs + j * 136 + wid * 16 + 8) = w1;
        w0.x = pk2(ksv[0], ksv[1]); w0.y = pk2(ksv[2], ksv[3]); w0.z = pk2(ksv[4], ksv[5]); w0.w = pk2(ksv[6], ksv[7]);
        w1.x = pk2(ksv[8], ksv[9]); w1.y = pk2(ksv[10], ksv[11]); w1.z = pk2(ksv[12], ksv[13]); w1.w = pk2(ksv[14], ksv[15]);
        *(u32x4*)(Ks + j * 136 + wid * 16) = w0; *(u32x4*)(Ks + j * 136 + wid * 16 + 8) = w1;
        w0.x = pk2(qiv[0], qiv[1]); w0.y = pk2(qiv[2], qiv[3]); w0.z = pk2(qiv[8], qiv[9]); w0.w = pk2(qiv[10], qiv[11]);
        w1.x = pk2(qiv[4], qiv[5]); w1.y = pk2(qiv[6], qiv[7]); w1.z = pk2(qiv[12], qiv[13]); w1.w = pk2(qiv[14], qiv[15]);
        bf16_t* qo = QI + (((size_t)u * 2 + dir) * 64 + j) * 128 + wid * 16;
        *(u32x4*)qo = w0; *(u32x4*)(qo + 8) = w1; }
      __syncthreads();
      { const int ti = wid >> 1, tj0 = 2 * (wid & 1);
#pragma unroll
        for (int tt = 0; tt < 2; ++tt) { const int tj = tj0 + tt; f32x4 acc = {0, 0, 0, 0};
#pragma unroll
          for (int s = 0; s < 4; ++s) { bf16x8 a = *(const bf16x8*)(Qs + (16 * ti + fr) * 136 + 32 * s + 8 * fq), bb = *(const bf16x8*)(Ks + (16 * tj + fr) * 136 + 32 * s + 8 * fq);
            acc = MFMA16(bb, a, acc); }
          const int i = 16 * ti + fr;
#pragma unroll
          for (int jj = 0; jj < 4; ++jj) { int jc = 16 * tj + 4 * fq + jj; bool keep = dir ? (jc >= i) : (jc <= i); if (!keep) acc[jj] = 0.f; }
          u32x2 w; w.x = pk2(acc[0], acc[1]); w.y = pk2(acc[2], acc[3]);
          *(u32x2*)(Pm + i * 136 + dir * 64 + 16 * tj + 4 * fq) = w; }
        const int dk = tid >> 2, part = tid & 3;
        bf16_t* ko = KST + (((size_t)u * 2 + dir) * 128 + dk) * 64 + part * 16;
        *(u32x4*)ko = *(const u32x4*)(KT + dk * 72 + part * 16); *(u32x4*)(ko + 8) = *(const u32x4*)(KT + dk * 72 + part * 16 + 8); }
      __syncthreads();
    }
    { const int dv = tid >> 1, part = tid & 1; bf16_t* vo = VT + ((size_t)u * 256 + dv) * 64 + part * 32;
#pragma unroll
      for (int q = 0; q < 4; ++q) *(u32x4*)(vo + q * 8) = *(const u32x4*)(VTl + dv * 72 + part * 32 + q * 8); }
    if (!isctx) {
#pragma unroll
      for (int tt = 0; tt < 2; ++tt) { const int tn = 2 * wid + tt;
        bf16x8 bfv[4];
#pragma unroll
        for (int s = 0; s < 4; ++s) bfv[s] = *(const bf16x8*)(VTl + (16 * tn + fr) * 72 + ((32 * s + 8 * fq) & 63));
#pragma unroll
        for (int ti = 0; ti < 4; ++ti) { f32x4 acc = {0, 0, 0, 0};
#pragma unroll
          for (int s = 0; s < 4; ++s) { bf16x8 a = *(const bf16x8*)(Pm + (16 * ti + fr) * 136 + 32 * s + 8 * fq); acc = MFMA16(bfv[s], a, acc); }
          u32x2 w; w.x = pk2(acc[0], acc[1]); w.y = pk2(acc[2], acc[3]);
          *(u32x2*)(O + (row0 + 16 * ti + fr) * 1024 + hd * 256 + 16 * tn + 4 * fq) = w; } }
    }
    __syncthreads();
  }
}

DI int fpad(int n) { return n + (n >> 4); }
DI int otid() { int t = threadIdx.x; asm volatile("" : "+v"(t)); return t; }
DI f32x2 cmul(f32x2 a, f32x2 b) { return (f32x2){a.x * b.x - a.y * b.y, a.x * b.y + a.y * b.x}; }
DI f32x2 cmulc(f32x2 a, f32x2 b) { return (f32x2){a.x * b.x + a.y * b.y, a.y * b.x - a.x * b.y}; }
DI f32x2 twid(float frac) { return (f32x2){__builtin_amdgcn_cosf(frac), -__builtin_amdgcn_sinf(frac)}; }
template <bool INV> DI void dft4(f32x2& a, f32x2& b, f32x2& c, f32x2& d) {
  f32x2 s0 = a + c, s1 = a - c, s2 = b + d, s3 = b - d;
  f32x2 t = INV ? (f32x2){-s3.y, s3.x} : (f32x2){s3.y, -s3.x};
  a = s0 + s2; c = s0 - s2; b = s1 + t; d = s1 - t;
}
template <bool INV> DI void dft16(f32x2 (&x)[16]) {
  constexpr float CS[10] = {1.f, 0.9238795325112867f, 0.7071067811865476f, 0.3826834323650898f, 0.f, -0.3826834323650898f, -0.7071067811865476f, -0.9238795325112867f, -1.f, -0.9238795325112867f};
  constexpr float SN[10] = {0.f, 0.3826834323650898f, 0.7071067811865476f, 0.9238795325112867f, 1.f, 0.9238795325112867f, 0.7071067811865476f, 0.3826834323650898f, 0.f, -0.3826834323650898f};
#pragma unroll
  for (int a = 0; a < 4; ++a) dft4<INV>(x[a], x[a + 4], x[a + 8], x[a + 12]);
#pragma unroll
  for (int a = 1; a < 4; ++a)
#pragma unroll
    for (int c = 1; c < 4; ++c) { const int m = a * c; f32x2 w = {CS[m], INV ? SN[m] : -SN[m]}; x[a + 4 * c] = cmul(x[a + 4 * c], w); }
#pragma unroll
  for (int c = 0; c < 4; ++c) dft4<INV>(x[4 * c], x[4 * c + 1], x[4 * c + 2], x[4 * c + 3]);
}
#define OIDX(k) (4 * ((k) & 3) + ((k) >> 2))

DI void twpow(f32x2 w1, f32x2 (&w)[16]) {
  w[1] = w1; w[2] = cmul(w1, w1); w[4] = cmul(w[2], w[2]); w[8] = cmul(w[4], w[4]);
  w[3] = cmul(w[2], w[1]); w[5] = cmul(w[4], w[1]); w[6] = cmul(w[4], w[2]); w[7] = cmul(w[4], w[3]);
  w[9] = cmul(w[8], w[1]); w[10] = cmul(w[8], w[2]); w[11] = cmul(w[8], w[3]); w[12] = cmul(w[8], w[4]);
  w[13] = cmul(w[8], w[5]); w[14] = cmul(w[8], w[6]); w[15] = cmul(w[8], w[7]);
}
template <bool INV> DI void pass16(f32x2* X, int id, int ls) {
  const int s = 1 << ls, n0 = id & (s - 1), base = (id >> ls) << (ls + 4);
  f32x2 w[16]; twpow(twid((float)n0 / (float)(16 << ls)), w);
  f32x2 v[16];
#pragma unroll
  for (int k = 0; k < 16; ++k) v[k] = X[fpad(base + k * s + n0)];
  if (INV) {
#pragma unroll
    for (int k = 1; k < 16; ++k) v[k] = cmulc(v[k], w[k]);
    dft16<true>(v);
#pragma unroll
    for (int k = 0; k < 16; ++k) X[fpad(base + k * s + n0)] = v[OIDX(k)];
  } else {
    dft16<false>(v);
#pragma unroll
    for (int k = 0; k < 16; ++k) { f32x2 y = v[OIDX(k)]; if (k) y = cmul(y, w[k]); X[fpad(base + k * s + n0)] = y; }
  }
}
DI void fft_fwd23(f32x2* X) {
  __syncthreads();
  { const int tid = otid();
#pragma unroll
  for (int q = 0; q < 2; ++q) pass16<false>(X, tid + 512 * q, 8); }
  __syncthreads();
  { const int tid = otid();
#pragma unroll
  for (int q = 0; q < 2; ++q) pass16<false>(X, tid + 512 * q, 4); }
  __syncthreads();
}
DI void f1_store(f32x2* X, int n0, f32x2 a, f32x2 b, f32x2 c, f32x2 d) {
  dft4<false>(a, b, c, d);
  f32x2 w1 = twid((float)n0 * (1.f / 16384.f)), w2 = cmul(w1, w1), w3 = cmul(w2, w1);
  X[fpad(n0)] = a; X[fpad(4096 + n0)] = cmul(b, w1); X[fpad(8192 + n0)] = cmul(c, w2); X[fpad(12288 + n0)] = cmul(d, w3);
}

DI void fft_channel(const P& p, int c, f32x2* G1, f32x2* G2, f32x2* G3) {
  f32x2* X = (f32x2*)g_smem;
  const float* hf = (const float*)(p.ws + OFF_HT) + (size_t)c * 16384; const float* hb = hf + (size_t)1024 * 16384;
  float* zc0 = (float*)(p.ws + OFF_ZC) + (size_t)c * 16384; float* zc1 = zc0 + (size_t)1024 * 16384;
  const float skip = p.skip[c];
  const float R2 = 0.7071067811865476f;
#pragma unroll 1
  for (int rnd = 0; rnd < 2; ++rnd) {
#pragma unroll 1
    for (int q0 = 0; q0 < 8; q0 += 4) {
      const int tid = otid();
      float f[4][4], g[4][4];
#pragma unroll
      for (int qq = 0; qq < 4; ++qq)
#pragma unroll
        for (int jx = 0; jx < 4; ++jx) { const int n = tid + 512 * (q0 + qq) + 4096 * jx; f[qq][jx] = hf[n]; g[qq][jx] = n ? hb[16384 - n] : 0.f; }
#pragma unroll
      for (int qq = 0; qq < 4; ++qq) { const int n0 = tid + 512 * (q0 + qq); f32x2 v[4];
        if (rnd == 0) {
#pragma unroll
          for (int jx = 0; jx < 4; ++jx) v[jx] = (f32x2){f[qq][jx] + g[qq][jx], 0.f};
        } else { const f32x2 w0 = twid((float)n0 * (1.f / 32768.f));
          const f32x2 w1 = cmul(w0, (f32x2){R2, -R2}), w2 = (f32x2){w0.y, -w0.x}, w3 = cmul(w0, (f32x2){-R2, -R2});
          v[0] = w0 * (f[qq][0] - g[qq][0]); v[1] = w1 * (f[qq][1] - g[qq][1]); v[2] = w2 * (f[qq][2] - g[qq][2]); v[3] = w3 * (f[qq][3] - g[qq][3]); }
        f1_store(X, n0, v[0], v[1], v[2], v[3]); }
    }
    fft_fwd23(X);
    f32x2* Gk = rnd ? G2 : G1;
#pragma unroll 1
    for (int q = 0; q < 2; ++q) { const int id = otid() + 512 * q; f32x2 v[16];
#pragma unroll
      for (int k = 0; k < 16; ++k) v[k] = X[fpad(id * 16 + k)];
      dft16<false>(v);
#pragma unroll
      for (int k = 0; k < 16; k += 2) { f32x2 a = v[OIDX(k)] * (1.f / 32768.f), b = v[OIDX(k + 1)] * (1.f / 32768.f); *(f32x4*)(Gk + id * 16 + k) = (f32x4){a.x, a.y, b.x, b.y}; } }
    __syncthreads();
  }
#pragma unroll 1
  for (int rnd = 0; rnd < 2; ++rnd) {
#pragma unroll 1
    for (int q0 = 0; q0 < 8; q0 += 4) {
      const int tid = otid();
      f32x2 z[4][4];
#pragma unroll
      for (int qq = 0; qq < 4; ++qq)
#pragma unroll
        for (int jx = 0; jx < 4; ++jx) { const int n = tid + 512 * (q0 + qq) + 4096 * jx; z[qq][jx] = (f32x2){zc0[n], zc1[n]}; }
#pragma unroll
      for (int qq = 0; qq < 4; ++qq) { const int n0 = tid + 512 * (q0 + qq);
        if (rnd) { const f32x2 w0 = twid((float)n0 * (1.f / 32768.f));
          const f32x2 w1 = cmul(w0, (f32x2){R2, -R2}), w2 = (f32x2){w0.y, -w0.x}, w3 = cmul(w0, (f32x2){-R2, -R2});
          z[qq][0] = cmul(z[qq][0], w0); z[qq][1] = cmul(z[qq][1], w1); z[qq][2] = cmul(z[qq][2], w2); z[qq][3] = cmul(z[qq][3], w3); }
        f1_store(X, n0, z[qq][0], z[qq][1], z[qq][2], z[qq][3]); }
    }
    fft_fwd23(X);
    const f32x2* Gk = rnd ? G2 : G1;
#pragma unroll 1
    for (int q = 0; q < 2; ++q) { const int id = otid() + 512 * q; f32x2 v[16], w[16];
      f32x4 kk[8];
#pragma unroll
      for (int k = 0; k < 8; ++k) kk[k] = *(const f32x4*)(Gk + id * 16 + 2 * k);
#pragma unroll
      for (int k = 0; k < 16; ++k) v[k] = X[fpad(id * 16 + k)];
      dft16<false>(v);
#pragma unroll
      for (int k = 0; k < 16; k += 2) { w[k] = cmul(v[OIDX(k)], (f32x2){kk[k >> 1].x, kk[k >> 1].y}); w[k + 1] = cmul(v[OIDX(k + 1)], (f32x2){kk[k >> 1].z, kk[k >> 1].w}); }
      dft16<true>(w);
#pragma unroll
      for (int k = 0; k < 16; ++k) X[fpad(id * 16 + k)] = w[OIDX(k)]; }
    __syncthreads();
    { const int tid = otid();
#pragma unroll
    for (int q = 0; q < 2; ++q) pass16<true>(X, tid + 512 * q, 4); }
    __syncthreads();
    { const int tid = otid();
#pragma unroll
    for (int q = 0; q < 2; ++q) pass16<true>(X, tid + 512 * q, 8); }
    __syncthreads();
#pragma unroll 1
    for (int q0 = 0; q0 < 8; q0 += 4) {
      const int tid = otid();
      f32x2 r1[4][4], zz[4][4];
      if (rnd) {
#pragma unroll
        for (int qq = 0; qq < 4; ++qq)
#pragma unroll
          for (int jx = 0; jx < 4; ++jx) { const int n = tid + 512 * (q0 + qq) + 4096 * jx; r1[qq][jx] = G3[n]; zz[qq][jx] = (f32x2){zc0[n], zc1[n]}; }
      }
#pragma unroll
      for (int qq = 0; qq < 4; ++qq) { const int n0 = tid + 512 * (q0 + qq);
        const f32x2 t1 = twid((float)n0 * (1.f / 16384.f)), t2 = cmul(t1, t1), t3 = cmul(t2, t1);
        f32x2 v[4];
        v[0] = X[fpad(n0)]; v[1] = cmulc(X[fpad(4096 + n0)], t1); v[2] = cmulc(X[fpad(8192 + n0)], t2); v[3] = cmulc(X[fpad(12288 + n0)], t3);
        dft4<true>(v[0], v[1], v[2], v[3]);
        if (rnd == 0) {
#pragma unroll
          for (int jx = 0; jx < 4; ++jx) G3[n0 + 4096 * jx] = v[jx];
        } else { const f32x2 w0 = twid((float)n0 * (1.f / 32768.f));
          const f32x2 wj[4] = {w0, cmul(w0, (f32x2){R2, -R2}), (f32x2){w0.y, -w0.x}, cmul(w0, (f32x2){-R2, -R2})};
#pragma unroll
          for (int jx = 0; jx < 4; ++jx) { f32x2 y = r1[qq][jx] + cmulc(v[jx], wj[jx]) + zz[qq][jx] * skip; zc0[n0 + 4096 * jx] = y.x; zc1[n0 + 4096 * jx] = y.y; } } }
    }
    __syncthreads();
  }
}

DI bf16x8 pack8(const f32x16& x, int s) {
  u32x4 r; r.x = pk2(x[8 * s], x[8 * s + 1]); r.y = pk2(x[8 * s + 2], x[8 * s + 3]); r.z = pk2(x[8 * s + 4], x[8 * s + 5]); r.w = pk2(x[8 * s + 6], x[8 * s + 7]);
  return __builtin_bit_cast(bf16x8, r);
}
constexpr int SEGLEN = 17, NSEG = 16;
DI void scan_step_addr(const P& p, int b, int hd, int dir, int step, bool& isctx, int& n, size_t& unit) {
  isctx = step < 4;
  if (isctx) { n = dir ? 3 - step : step; unit = 2048 + (size_t)(b * 4 + n) * 4 + hd; }
  else { int m = step - 4; n = dir ? 255 - m : m; unit = (size_t)(b * 256 + n) * 4 + hd; }
}
DI void scan_decay(f32x16 (&S)[4], float d0, float d1, int h2) {
#pragma unroll
  for (int a = 0; a < 4; ++a)
#pragma unroll
    for (int i = 0; i < 16; ++i) { const int src = 32 * (a & 1) + (i & 3) + 8 * (i >> 2) + 4 * h2; S[a][i] *= __shfl((a < 2) ? d0 : d1, src, 64); }
}
template <int V> struct IC { static constexpr int value = V; };
template <bool OUT>
DI void scan_segment(const P& p, f32x16 (&S)[4], int b, int hd, int dir, int s0, int s1, float& dp0, float& dp1) {
  const int tid = threadIdx.x, wid = tid >> 6, lane = tid & 63, r = lane & 31, h2 = lane >> 5;
  const bf16_t* QI = (const bf16_t*)(p.ws + OFF_QI); const bf16_t* KST = (const bf16_t*)(p.ws + OFF_KST); const bf16_t* VT = (const bf16_t*)(p.ws + OFF_VT);
  const float* DD = (const float*)(p.ws + OFF_DD); bf16_t* OFB = (bf16_t*)(p.ws + OFF_OFB);
  char* img = g_smem;
  bf16x8 kq[2][2], kk[2][2], vb[2][4]; float d0[2], d1[2];
  auto fetch = [&](int step, auto PP, bool with_v) {
    constexpr int Q = decltype(PP)::value;
    bool isctx; int n; size_t unit; scan_step_addr(p, b, hd, dir, step, isctx, n, unit);
    const bf16_t* qi = QI + (unit * 2 + dir) * 8192; const bf16_t* kst = KST + (unit * 2 + dir) * 8192; const float* dd = DD + (unit * 2 + dir) * 128;
    const bf16_t* vt = VT + unit * 16384 + (size_t)(wid * 32) * 64;
#pragma unroll
    for (int e = 0; e < 2; ++e) { const int f = 2 * wid + e;
      if (OUT) { const int m = f >> 3, a = (f >> 1) & 3, s = f & 1; kq[Q][e] = *(const bf16x8*)(qi + (32 * m + r) * 128 + a * 32 + s * 16 + h2 * 8); }
      { const int s = f >> 2, a = f & 3; kk[Q][e] = *(const bf16x8*)(kst + (32 * a + r) * 64 + s * 16 + h2 * 8); } }
    if (with_v) {
#pragma unroll
      for (int s = 0; s < 4; ++s) vb[Q][s] = *(const bf16x8*)(vt + r * 64 + s * 16 + h2 * 8); }
    d0[Q] = dd[lane]; d1[Q] = dd[64 + lane];
  };
  auto fetch_v = [&](int step, auto PP) {
    constexpr int Q = decltype(PP)::value;
    bool isctx; int n; size_t unit; scan_step_addr(p, b, hd, dir, step, isctx, n, unit);
    const bf16_t* vt = VT + unit * 16384 + (size_t)(wid * 32) * 64;
#pragma unroll
    for (int s = 0; s < 4; ++s) vb[Q][s] = *(const bf16x8*)(vt + r * 64 + s * 16 + h2 * 8);
  };
  auto body = [&](int step, auto PP) {
    constexpr int Q = decltype(PP)::value;
    char* ib = img + Q * 32768;
#pragma unroll
    for (int e = 0; e < 2; ++e) { const int f = 2 * wid + e;
      if (OUT) *(bf16x8*)(ib + f * 1024 + lane * 16) = kq[Q][e];
      *(bf16x8*)(ib + (16 + f) * 1024 + lane * 16) = kk[Q][e]; }
    const float c0 = d0[Q], c1 = d1[Q];
    bool isctx; int n; size_t unit; scan_step_addr(p, b, hd, dir, step, isctx, n, unit);
    __syncthreads();
    fetch(min(step + 2, s1 - 1), PP, false);
    if (OUT && !isctx) {
      f32x16 o0, o1;
#pragma unroll
      for (int i = 0; i < 16; ++i) { o0[i] = 0.f; o1[i] = 0.f; }
#pragma unroll
      for (int a = 0; a < 4; ++a)
#pragma unroll
        for (int s = 0; s < 2; ++s) { bf16x8 sb = pack8(S[a], s);
          bf16x8 q0 = *(const bf16x8*)(ib + (a * 2 + s) * 1024 + lane * 16), q1 = *(const bf16x8*)(ib + (8 + a * 2 + s) * 1024 + lane * 16);
          o0 = MFMA32(q0, sb, o0); o1 = MFMA32(q1, sb, o1); }
      const int tl = otid(), ro = tl & 31, ho = (tl >> 5) & 1;
      bf16_t* ob = OFB + (size_t)dir * T * 1024 + ((size_t)b * 16384 + (size_t)n * 64 + 4 * ho) * 1024 + hd * 256 + wid * 32 + ro;
#pragma unroll
      for (int i = 0; i < 16; ++i) { const int row = (i & 3) + 8 * (i >> 2); ob[(size_t)row * 1024] = f2bf(o0[i]); ob[(size_t)(32 + row) * 1024] = f2bf(o1[i]); }
    }
    if (!OUT || step + 1 < s1) {
      scan_decay(S, c0, c1, h2);
      if (!OUT && wid == 0) { dp0 *= c0; dp1 *= c1; }
#pragma unroll
      for (int s = 0; s < 4; ++s)
#pragma unroll
        for (int a = 0; a < 4; ++a) { bf16x8 ka = *(const bf16x8*)(ib + (16 + s * 4 + a) * 1024 + lane * 16); S[a] = MFMA32(ka, vb[Q][s], S[a]); }
    }
    fetch_v(min(step + 2, s1 - 1), PP);
  };
  fetch(s0, IC<0>{}, true); fetch(min(s0 + 1, s1 - 1), IC<1>{}, true);
#pragma unroll 1
  for (int step = s0; step < s1; step += 2) {
    body(step, IC<0>{});
    if (step + 1 < s1) body(step + 1, IC<1>{});
  }
  __syncthreads();
}
DI void gla_scan_A(const P& p, int u) {
  const int tid = threadIdx.x, wid = tid >> 6, lane = tid & 63;
  const int chain = u >> 4, g = u & 15; if (g == NSEG - 1) return;
  const int b = chain >> 3, hd = (chain >> 1) & 3, dir = chain & 1;
  float* SLOC = (float*)(p.ws + OFF_SLOC); float* DSEG = (float*)(p.ws + OFF_DSEG);
  f32x16 S[4];
#pragma unroll
  for (int a = 0; a < 4; ++a)
#pragma unroll
    for (int i = 0; i < 16; ++i) S[a][i] = 0.f;
  float dp0 = 1.f, dp1 = 1.f;
  const int s0 = g * SEGLEN, s1 = min(s0 + SEGLEN, 260);
  scan_segment<false>(p, S, b, hd, dir, s0, s1, dp0, dp1);
  float* so = SLOC + ((size_t)u * 8 + wid) * 4096 + lane;
#pragma unroll
  for (int a = 0; a < 4; ++a)
#pragma unroll
    for (int i = 0; i < 16; ++i) so[(a * 16 + i) * 64] = S[a][i];
  if (wid == 0) { DSEG[(size_t)u * 128 + lane] = dp0; DSEG[(size_t)u * 128 + 64 + lane] = dp1; }
}
DI void gla_scan_C(const P& p, int u) {
  const int tid = threadIdx.x, wid = tid >> 6, lane = tid & 63, h2 = lane >> 5;
  const int chain = u >> 4, g = u & 15;
  const int b = chain >> 3, hd = (chain >> 1) & 3, dir = chain & 1;
  const float* SLOC = (const float*)(p.ws + OFF_SLOC); const float* DSEG = (const float*)(p.ws + OFF_DSEG);
  f32x16 S[4];
#pragma unroll
  for (int a = 0; a < 4; ++a)
#pragma unroll
    for (int i = 0; i < 16; ++i) S[a][i] = 0.f;
#pragma unroll 1
  for (int gp = 0; gp < g; ++gp) {
    const float* si = SLOC + ((size_t)(chain * 16 + gp) * 8 + wid) * 4096 + lane; const float* dg = DSEG + (size_t)(chain * 16 + gp) * 128;
    const float g0 = dg[lane], g1 = dg[64 + lane];
    float sv[32];
#pragma unroll
    for (int e = 0; e < 32; ++e) sv[e] = si[e * 64];
    scan_decay(S, g0, g1, h2);
#pragma unroll
    for (int hh = 0; hh < 2; ++hh) {
      if (hh) {
#pragma unroll
        for (int e = 0; e < 32; ++e) sv[e] = si[(32 + e) * 64]; }
#pragma unroll
      for (int e = 0; e < 32; ++e) S[hh * 2 + (e >> 4)][e & 15] += sv[e]; }
  }
  float dpa = 1.f, dpb = 1.f;
  const int s0 = g * SEGLEN, s1 = min(s0 + SEGLEN, 260);
  scan_segment<true>(p, S, b, hd, dir, s0, s1, dpa, dpb);
}

DI void phase_global_a(const P& p, int bid, int nb) {
  for (int u = bid; u < 256; u += nb) gla_scan_A(p, u);
  f32x2* G = (f32x2*)(p.ws + OFF_FFTS) + (size_t)bid * 3 * 16384;
  for (int c = bid; c < 1024; c += nb) fft_channel(p, c, G, G + 16384, G + 32768);
}
DI void phase_global_b(const P& p, int bid, int nb) {
  for (int u = bid; u < 256; u += nb) gla_scan_C(p, u);
  const int tid = threadIdx.x; (void)tid;
  bf16_t* W2 = (bf16_t*)(p.ws + OFF_W2);
#pragma unroll 1
  for (int job = 0; job < 6; ++job) {
    const float* src; int ld, K, ncols, dstld, drow0, mode; bf16_t* dst;
    switch (job) {
      case 0: src = p.p_gla; ld = 2048; K = 1024; ncols = 2048; dst = W2 + W2_PM / 2; dstld = 2048; drow0 = 0; mode = 0; break;
      case 1: src = p.p_hy; ld = 2048; K = 1024; ncols = 2048; dst = W2 + W2_PM / 2 + 1024; dstld = 2048; drow0 = 0; mode = 0; break;
      case 2: src = p.w_out; ld = 2048; K = 2048; ncols = 2048; dst = W2 + W2_WOUT / 2; dstld = 2048; drow0 = 0; mode = 0; break;
      case 3: src = p.ffn_gate; ld = 5632; K = 2048; ncols = 5632; dst = W2 + W2_WGU / 2; dstld = 2048; drow0 = 0; mode = 1; break;
      case 4: src = p.ffn_up; ld = 5632; K = 2048; ncols = 5632; dst = W2 + W2_WGU / 2; dstld = 2048; drow0 = 128; mode = 1; break;
      default: src = p.ffn_down; ld = 2048; K = 5632; ncols = 2048; dst = W2 + W2_WD / 2; dstld = 5632; drow0 = 0; mode = 0; break; }
    wconv(src, ld, K, 0, ncols, dst, dstld, drow0, mode, bid, nb);
  }
}

DI void phase_mergeprep(const P& p, int bid, int nb) {
  const int tid = threadIdx.x, wid = tid >> 6, lane = tid & 63;
  bf16_t* AM = (bf16_t*)(p.ws + OFF_AM);
  {
    const bf16_t* O = (const bf16_t*)(p.ws + OFF_O); const bf16_t* G = (const bf16_t*)(p.ws + OFF_G);
    for (int row = bid * 8 + wid; row < T; row += nb * 8) {
      const int c0 = lane * 16; const bf16_t* op = O + (size_t)row * 1024 + c0;
      f32x4 v[4]; float ss = 0.f;
      const bf16_t* ofp = (const bf16_t*)(p.ws + OFF_OFB) + (size_t)row * 1024 + c0; const bf16_t* obp = ofp + (size_t)T * 1024;
      u32x4 f0 = *(const u32x4*)ofp, f1 = *(const u32x4*)(ofp + 8), b0 = *(const u32x4*)obp, b1 = *(const u32x4*)(obp + 8);
      const u32x4 i0 = *(const u32x4*)op, i1 = *(const u32x4*)(op + 8);
#pragma unroll
      for (int q = 0; q < 4; ++q) { const unsigned ia = q < 2 ? i0[2 * (q & 1)] : i1[2 * (q & 1)], ib = q < 2 ? i0[2 * (q & 1) + 1] : i1[2 * (q & 1) + 1];
        v[q] = (f32x4){bflo(ia), bfhi(ia), bflo(ib), bfhi(ib)};
        const unsigned fa = q < 2 ? f0[2 * (q & 1)] : f1[2 * (q & 1)], fb = q < 2 ? f0[2 * (q & 1) + 1] : f1[2 * (q & 1) + 1];
        const unsigned ba = q < 2 ? b0[2 * (q & 1)] : b1[2 * (q & 1)], bb = q < 2 ? b0[2 * (q & 1) + 1] : b1[2 * (q & 1) + 1];
        v[q].x += bflo(fa) + bflo(ba); v[q].y += bfhi(fa) + bfhi(ba); v[q].z += bflo(fb) + bflo(bb); v[q].w += bfhi(fb) + bfhi(bb);
        ss += v[q].x * v[q].x + v[q].y * v[q].y + v[q].z * v[q].z + v[q].w * v[q].w; }
      ss += __shfl_xor(ss, 1, 64); ss += __shfl_xor(ss, 2, 64); ss += __shfl_xor(ss, 4, 64); ss += __shfl_xor(ss, 8, 64);
      const float rstd = rsqrtf(ss * (1.f / 256.f) + 1e-6f);
      const bf16_t* gp = G + (size_t)row * 1024 + c0; u32x4 g0 = *(const u32x4*)gp, g1 = *(const u32x4*)(gp + 8);
      const float* nw = p.gla_norm + (c0 & 255);
      float gv[16];
#pragma unroll
      for (int e = 0; e < 4; ++e) { gv[2 * e] = bflo(g0[e]); gv[2 * e + 1] = bfhi(g0[e]); gv[8 + 2 * e] = bflo(g1[e]); gv[8 + 2 * e + 1] = bfhi(g1[e]); }
      float y[16];
#pragma unroll
      for (int e = 0; e < 16; ++e) y[e] = v[e >> 2][e & 3] * rstd * nw[e] * gv[e];
      u32x4 w0, w1;
      w0.x = pk2(y[0], y[1]); w0.y = pk2(y[2], y[3]); w0.z = pk2(y[4], y[5]); w0.w = pk2(y[6], y[7]);
      w1.x = pk2(y[8], y[9]); w1.y = pk2(y[10], y[11]); w1.z = pk2(y[12], y[13]); w1.w = pk2(y[14], y[15]);
      bf16_t* ap = AM + (size_t)row * 2048 + c0; *(u32x4*)ap = w0; *(u32x4*)(ap + 8) = w1;
    }
  }
  {
    f32x2* tile = (f32x2*)g_smem;
    const bf16_t* ZH = (const bf16_t*)(p.ws + OFF_ZH); const float* ZC = (const float*)(p.ws + OFF_ZC);
    for (int it = bid; it < 4096; it += nb) {
      const int tr = it >> 4, ct = it & 15; const int t0 = tr * 64, c0 = ct * 64;
      { const int c = tid >> 3, t8 = (tid & 7) * 8; const float* s0 = ZC + (size_t)(c0 + c) * 16384 + t0 + t8; const float* s1 = s0 + (size_t)1024 * 16384;
        const f32x4 a0 = *(const f32x4*)s0, a1 = *(const f32x4*)(s0 + 4), b0 = *(const f32x4*)s1, b1 = *(const f32x4*)(s1 + 4);
#pragma unroll
        for (int e = 0; e < 4; ++e) { tile[c * 65 + t8 + e] = (f32x2){a0[e], b0[e]}; tile[c * 65 + t8 + 4 + e] = (f32x2){a1[e], b1[e]}; } }
      __syncthreads();
      const int t = tid >> 3, cg8 = (tid & 7) * 8;
#pragma unroll
      for (int b = 0; b < 2; ++b) {
        float x0[8];
#pragma unroll
        for (int e = 0; e < 8; ++e) x0[e] = p.short_b[c0 + cg8 + e];
#pragma unroll
        for (int tap = 0; tap < 3; ++tap) { const int tt = t + tap - 1; if (tt < 0 || tt > 63) continue;
          u32x4 a = *(const u32x4*)(ZH + ((size_t)b * 16384 + t0 + tt) * 1024 + c0 + cg8);
          const float* w0 = p.short_w + tap * 3072 + c0 + cg8;
#pragma unroll
          for (int e = 0; e < 4; ++e) { x0[2 * e] += bflo(a[e]) * w0[2 * e]; x0[2 * e + 1] += bfhi(a[e]) * w0[2 * e + 1]; } }
        float y[8];
#pragma unroll
        for (int e = 0; e < 8; ++e) { f32x2 yy = tile[(cg8 + e) * 65 + t]; y[e] = (b ? yy.y : yy.x) * x0[e]; }
        u32x4 w; w.x = pk2(y[0], y[1]); w.y = pk2(y[2], y[3]); w.z = pk2(y[4], y[5]); w.w = pk2(y[6], y[7]);
        *(u32x4*)(AM + ((size_t)b * 16384 + t0 + t) * 2048 + 1024 + c0 + cg8) = w;
      }
      __syncthreads();
    }
  }
}

struct MergeSched { const bf16_t* A; const bf16_t* Bt; int bid, nb;
  DI bool next(int i, Unit& u) const { const int L = (i >> 1) * nb + bid; const int part = i & 1; if (L >= 1024) return false; unit_order(L, 128, 8, u.pm, u.pn);
    u.a = (const char*)(A + (size_t)u.pm * 256 * 2048 + part * 1024); u.b = (const char*)(Bt + (size_t)u.pn * 256 * 2048 + part * 1024); u.tag = part; return true; } };
DI void phase_merge(const P& p, int bid, int nb) {
  const bf16_t* AM = (const bf16_t*)(p.ws + OFF_AM); const bf16_t* PM = (const bf16_t*)(p.ws + OFF_W2 + W2_PM);
  const bf16_t* MG = (const bf16_t*)p.out; bf16_t* MERGED = (bf16_t*)(p.ws + OFF_MERGED);
  MergeSched S{AM, PM, bid, nb};
  auto E = [&](f32x4 (&acc)[2][2][4][2], const Unit& u, int wr, int wc, int fr, int fq) {
    const int brow = u.pm * 256, bcol = u.pn * 256;
    if (u.tag == 0) {
#pragma unroll
      for (int ai = 0; ai < 2; ++ai) {
        u32x4 ga[4][2], gb[4][2];
#pragma unroll
        for (int m = 0; m < 4; ++m) { const bf16_t* rp = MG + (size_t)(brow + ai * 128 + wr * 64 + m * 16 + fr) * 4096 + bcol + wc * 32 + 8 * fq;
#pragma unroll
          for (int bj = 0; bj < 2; ++bj) { ga[m][bj] = *(const u32x4*)(rp + bj * 128); gb[m][bj] = *(const u32x4*)(rp + 2048 + bj * 128); } }
        __builtin_amdgcn_sched_barrier(0);
#pragma unroll
        for (int m = 0; m < 4; ++m)
#pragma unroll
          for (int bj = 0; bj < 2; ++bj)
#pragma unroll
            for (int e = 0; e < 4; ++e) { float r0 = (1.f + __expf(-bflo(gb[m][bj][e]))) * __builtin_amdgcn_rcpf(1.f + __expf(-bflo(ga[m][bj][e]))), r1 = (1.f + __expf(-bfhi(gb[m][bj][e]))) * __builtin_amdgcn_rcpf(1.f + __expf(-bfhi(ga[m][bj][e])));
              acc[ai][bj][m][e >> 1][(e & 1) * 2] *= r0; acc[ai][bj][m][e >> 1][(e & 1) * 2 + 1] *= r1; }
      }
    } else {
      u32x4 gb[2][4][2];
#pragma unroll
      for (int ai = 0; ai < 2; ++ai)
#pragma unroll
        for (int m = 0; m < 4; ++m) { const bf16_t* rp = MG + (size_t)(brow + ai * 128 + wr * 64 + m * 16 + fr) * 4096 + 2048 + bcol + wc * 32 + 8 * fq;
#pragma unroll
          for (int bj = 0; bj < 2; ++bj) gb[ai][m][bj] = *(const u32x4*)(rp + bj * 128); }
      __builtin_amdgcn_sched_barrier(0);
#pragma unroll
      for (int ai = 0; ai < 2; ++ai)
#pragma unroll
        for (int m = 0; m < 4; ++m) { const size_t rowi = (size_t)(brow + ai * 128 + wr * 64 + m * 16 + fr);
#pragma unroll
          for (int bj = 0; bj < 2; ++bj) { float o[8];
#pragma unroll
            for (int e = 0; e < 4; ++e) { o[2 * e] = acc[ai][bj][m][e >> 1][(e & 1) * 2] * sigmoidf_(bflo(gb[ai][m][bj][e])); o[2 * e + 1] = acc[ai][bj][m][e >> 1][(e & 1) * 2 + 1] * sigmoidf_(bfhi(gb[ai][m][bj][e])); }
            u32x4 w; w.x = pk2(o[0], o[1]); w.y = pk2(o[2], o[3]); w.z = pk2(o[4], o[5]); w.w = pk2(o[6], o[7]);
            *(u32x4*)(MERGED + rowi * 2048 + bcol + bj * 128 + wc * 32 + 8 * fq) = w; } }
    }
  };
  gemm_stream(2048, 2048, 1024, S, E);
}

DI void phase_wout(const P& p, int bid, int nb) {
  const bf16_t* MERGED = (const bf16_t*)(p.ws + OFF_MERGED); const bf16_t* WO = (const bf16_t*)(p.ws + OFF_W2 + W2_WOUT); bf16_t* MIX = (bf16_t*)(p.ws + OFF_MIX);
  GridSched S{MERGED, WO, 2048, 2048, 128, 8, bid, nb};
  auto E = [&](f32x4 (&acc)[2][2][4][2], const Unit& u, int wr, int wc, int fr, int fq) { store_tile_bf16<0>(acc, MIX, 2048, u.pm * 256, u.pn * 256, 1.f, wr, wc, fr, fq); };
  gemm_stream(2048, 2048, 2048, S, E);
}

DI void phase_rowmid(const P& p, int bid, int nb) {
  const int tid = threadIdx.x, wid = tid >> 6, lane = tid & 63;
  const float* MOD = (const float*)(p.ws + OFF_MOD); const bf16_t* MIX = (const bf16_t*)(p.ws + OFF_MIX); bf16_t* HX2 = (bf16_t*)(p.ws + OFF_HX2); bf16_t* X1B = (bf16_t*)(p.ws + OFF_MIX);
  for (int row = bid * 8 + wid; row < T; row += nb * 8) {
    const float* md = MOD + (row >> 14) * 12288;
    float mv[32]; float ss = 0.f;
#pragma unroll
    for (int q = 0; q < 4; ++q) { u32x4 a = *(const u32x4*)(MIX + (size_t)row * 2048 + q * 512 + lane * 8);
#pragma unroll
      for (int e = 0; e < 4; ++e) { mv[q * 8 + 2 * e] = bflo(a[e]); mv[q * 8 + 2 * e + 1] = bfhi(a[e]); } }
#pragma unroll
    for (int e = 0; e < 32; ++e) ss += mv[e] * mv[e];
    ss = wave_sum(ss); const float rstd = rsqrtf(ss * (1.f / 2048.f) + 1e-6f);
    float ss2 = 0.f;
#pragma unroll
    for (int q = 0; q < 4; ++q)
#pragma unroll
      for (int hh = 0; hh < 2; ++hh) { const int idx = q * 512 + lane * 8 + hh * 4;
        f32x4 xv = *(const f32x4*)(p.x + (size_t)row * 2048 + idx), w = *(const f32x4*)(p.n_post_mix + idx), g1 = *(const f32x4*)(md + 4096 + idx);
#pragma unroll
        for (int e = 0; e < 4; ++e) { float x1 = xv[e] + g1[e] * (mv[q * 8 + hh * 4 + e] * rstd * w[e]); mv[q * 8 + hh * 4 + e] = x1; ss2 += x1 * x1; } }
    ss2 = wave_sum(ss2); const float rstd2 = rsqrtf(ss2 * (1.f / 2048.f) + 1e-6f);
#pragma unroll
    for (int q = 0; q < 4; ++q) { const int idx = q * 512 + lane * 8; float y[8];
#pragma unroll
      for (int hh = 0; hh < 2; ++hh) { f32x4 w = *(const f32x4*)(p.n_pre_ffn + idx + hh * 4), s2 = *(const f32x4*)(md + 8192 + idx + hh * 4), h2 = *(const f32x4*)(md + 6144 + idx + hh * 4);
#pragma unroll
        for (int e = 0; e < 4; ++e) y[hh * 4 + e] = mv[q * 8 + hh * 4 + e] * rstd2 * w[e] * (1.f + s2[e]) + h2[e]; }
      u32x4 o; o.x = pk2(y[0], y[1]); o.y = pk2(y[2], y[3]); o.z = pk2(y[4], y[5]); o.w = pk2(y[6], y[7]);
      *(u32x4*)(HX2 + (size_t)row * 2048 + idx) = o;
      u32x4 xo; xo.x = pk2(mv[q * 8], mv[q * 8 + 1]); xo.y = pk2(mv[q * 8 + 2], mv[q * 8 + 3]); xo.z = pk2(mv[q * 8 + 4], mv[q * 8 + 5]); xo.w = pk2(mv[q * 8 + 6], mv[q * 8 + 7]);
      *(u32x4*)(X1B + (size_t)row * 2048 + idx) = xo; }
  }
}

DI void phase_ffn1(const P& p, int bid, int nb) {
  const bf16_t* HX2 = (const bf16_t*)(p.ws + OFF_HX2); const bf16_t* WGU = (const bf16_t*)(p.ws + OFF_W2 + W2_WGU); bf16_t* HID = (bf16_t*)(p.ws + OFF_HID);
  GridSched S{HX2, WGU, 2048, 2048, 128, 44, bid, nb};
  auto E = [&](f32x4 (&acc)[2][2][4][2], const Unit& u, int wr, int wc, int fr, int fq) {
#pragma unroll
    for (int ai = 0; ai < 2; ++ai)
#pragma unroll
      for (int m = 0; m < 4; ++m) { float o[8];
#pragma unroll
        for (int n = 0; n < 2; ++n)
#pragma unroll
          for (int jx = 0; jx < 4; ++jx) { float gte = acc[ai][0][m][n][jx], up = acc[ai][1][m][n][jx]; o[n * 4 + jx] = gte * sigmoidf_(gte) * up; }
        u32x4 w; w.x = pk2(o[0], o[1]); w.y = pk2(o[2], o[3]); w.z = pk2(o[4], o[5]); w.w = pk2(o[6], o[7]);
        *(u32x4*)(HID + (size_t)(u.pm * 256 + ai * 128 + wr * 64 + m * 16 + fr) * 5632 + u.pn * 128 + wc * 32 + 8 * fq) = w; }
  };
  gemm_stream(2048, 2048, 2048, S, E);
}
DI void phase_ffn2(const P& p, int bid, int nb) {
  const bf16_t* HID = (const bf16_t*)(p.ws + OFF_HID); const bf16_t* WD = (const bf16_t*)(p.ws + OFF_W2 + W2_WD); bf16_t* FFN = (bf16_t*)(p.ws + OFF_FFN);
  GridSched S{HID, WD, 5632, 5632, 128, 8, bid, nb};
  auto E = [&](f32x4 (&acc)[2][2][4][2], const Unit& u, int wr, int wc, int fr, int fq) { store_tile_bf16<0>(acc, FFN, 2048, u.pm * 256, u.pn * 256, 1.f, wr, wc, fr, fq); };
  gemm_stream(5632, 5632, 5632, S, E);
}
DI void phase_final(const P& p, int bid, int nb) {
  const int tid = threadIdx.x, wid = tid >> 6, lane = tid & 63;
  const float* MOD = (const float*)(p.ws + OFF_MOD); const bf16_t* FFN = (const bf16_t*)(p.ws + OFF_FFN); const bf16_t* X1B = (const bf16_t*)(p.ws + OFF_MIX);
  for (int row = bid * 8 + wid; row < T; row += nb * 8) {
    const float* md = MOD + (row >> 14) * 12288;
    float mv[32]; float ss = 0.f;
#pragma unroll
    for (int q = 0; q < 4; ++q) { u32x4 a = *(const u32x4*)(FFN + (size_t)row * 2048 + q * 512 + lane * 8);
#pragma unroll
      for (int e = 0; e < 4; ++e) { mv[q * 8 + 2 * e] = bflo(a[e]); mv[q * 8 + 2 * e + 1] = bfhi(a[e]); } }
#pragma unroll
    for (int e = 0; e < 32; ++e) ss += mv[e] * mv[e];
    ss = wave_sum(ss); const float rstd = rsqrtf(ss * (1.f / 2048.f) + 1e-6f);
#pragma unroll
    for (int q = 0; q < 4; ++q)
#pragma unroll
      for (int hh = 0; hh < 2; ++hh) { const int idx = q * 512 + lane * 8 + hh * 4;
        const u32x2 xb = *(const u32x2*)(X1B + (size_t)row * 2048 + idx);
        f32x4 xv = {bflo(xb.x), bfhi(xb.x), bflo(xb.y), bfhi(xb.y)}, w = *(const f32x4*)(p.n_post_ffn + idx), g2 = *(const f32x4*)(md + 10240 + idx);
#pragma unroll
        for (int e = 0; e < 4; ++e) xv[e] += g2[e] * (mv[q * 8 + hh * 4 + e] * rstd * w[e]);
        *(f32x4*)(p.out + (size_t)row * 2048 + idx) = xv; }
  }
}

constexpr int NPHASE = 13;
#define RUN_PH(k, call) do { if (ph_lo <= (k) && (k) < ph_hi) { if ((k) > ph_lo) grid.sync(); call; } } while (0)
__global__ void __launch_bounds__(NTHREADS) hybrid_layer_kernel(P p, int ph_lo, int ph_hi) {
  cg::grid_group grid = cg::this_grid();
  const int bid = blockIdx.x, nb = gridDim.x;
  RUN_PH(0, phase_prep(p, bid, nb));
  RUN_PH(1, phase_pre(p, bid, nb));
  RUN_PH(2, phase_gemm1(p, bid, nb));
  RUN_PH(3, phase_local(p, bid, nb));
  RUN_PH(4, phase_global_a(p, bid, nb));
  RUN_PH(5, phase_global_b(p, bid, nb));
  RUN_PH(6, phase_mergeprep(p, bid, nb));
  RUN_PH(7, phase_merge(p, bid, nb));
  RUN_PH(8, phase_wout(p, bid, nb));
  RUN_PH(9, phase_rowmid(p, bid, nb));
  RUN_PH(10, phase_ffn1(p, bid, nb));
  RUN_PH(11, phase_ffn2(p, bid, nb));
  RUN_PH(12, phase_final(p, bid, nb));
}

extern "C" void kernel_launch(void* const* d_in, const int* in_sizes, int n_in, void* d_out, int out_size, void* d_ws, size_t ws_size, hipStream_t stream) {
  (void)in_sizes; (void)n_in; (void)out_size;
  if (ws_size < WS_NEEDED) { fprintf(stderr, "workspace too small: %zu < %zu\n", ws_size, (size_t)WS_NEEDED); return; }
  P p{};
  const float** f = (const float**)&p;
  for (int i = 0; i < 31; ++i) f[i] = (const float*)d_in[i];
  p.out = (float*)d_out; p.ws = (char*)d_ws;
  static int grid_blocks = 0;
  if (!grid_blocks) {
    hipFuncSetAttribute((const void*)hybrid_layer_kernel, hipFuncAttributeMaxDynamicSharedMemorySize, SMEM_BYTES);
    int dev = 0, cus = 0, per_cu = 0;
    hipGetDevice(&dev);
    hipDeviceGetAttribute(&cus, hipDeviceAttributeMultiprocessorCount, dev);
    hipOccupancyMaxActiveBlocksPerMultiprocessor(&per_cu, hybrid_layer_kernel, NTHREADS, SMEM_BYTES);
    if (per_cu < 1) per_cu = 1;
    grid_blocks = cus * 1;
  }
#if SINGLE_LAUNCH
  int lo = 0, hi = NPHASE;
  void* args[] = {&p, &lo, &hi};
  hipError_t e = hipLaunchCooperativeKernel((void*)hybrid_layer_kernel, dim3(grid_blocks), dim3(NTHREADS), args, SMEM_BYTES, stream);
  if (e != hipSuccess) fprintf(stderr, "cooperative launch failed: %s (grid %d)\n", hipGetErrorString(e), grid_blocks);
#else
  for (int ph = 0; ph < NPHASE; ++ph) hybrid_layer_kernel<<<grid_blocks, NTHREADS, SMEM_BYTES, stream>>>(p, ph, ph + 1);
#endif
}
```

```cpp
#include <hip/hip_runtime.h>
#include <hip/hip_cooperative_groups.h>
#include <cstdio>
namespace cg = cooperative_groups;

#ifndef SINGLE_LAUNCH
#define SINGLE_LAUNCH 1
#endif

#define DI __device__ __forceinline__
#define LAS __attribute__((address_space(3)))
typedef unsigned short bf16_t;
typedef short bf16x8 __attribute__((ext_vector_type(8)));
typedef float f32x2 __attribute__((ext_vector_type(2)));
typedef float f32x4 __attribute__((ext_vector_type(4)));
typedef float f32x16 __attribute__((ext_vector_type(16)));
typedef unsigned u32x2 __attribute__((ext_vector_type(2)));
typedef unsigned u32x4 __attribute__((ext_vector_type(4)));
typedef __bf16 bfv2 __attribute__((ext_vector_type(2)));

constexpr int T = 32768, TC = 33280, SEQ = 16384, D = 2048;
constexpr size_t MiB = 1048576;
constexpr int SMEM_BYTES = 147456;
constexpr int NTHREADS = 512;

constexpr size_t OFF_MOD = 0, OFF_HDN = 1 * MiB, OFF_LR = 4 * MiB, OFF_DD = 10 * MiB;
constexpr size_t OFF_HX = 16 * MiB, OFF_WIN = 146 * MiB, OFF_HT = 187 * MiB, OFF_QKV = 315 * MiB, OFF_G = 445 * MiB, OFF_ZH = 509 * MiB;
constexpr size_t OFF_O = 701 * MiB, OFF_ZC = 829 * MiB, OFF_VT = 957 * MiB, OFF_QI = 16 * MiB, OFF_KST = 81 * MiB;
constexpr size_t OFF_FFTS = 315 * MiB, OFF_AM = 16 * MiB, OFF_W2 = 315 * MiB, OFF_MERGED = 187 * MiB, OFF_MIX = 445 * MiB;
constexpr size_t OFF_HX2 = 187 * MiB, OFF_HID = 573 * MiB, OFF_FFN = 16 * MiB;
constexpr size_t OFF_SLOC = 146 * MiB, OFF_DSEG = 180 * MiB;
constexpr size_t OFF_OFB = 187 * MiB;
constexpr size_t WS_NEEDED = 1022 * MiB;
constexpr size_t W2_PM = 0, W2_WOUT = 8388608, W2_WGU = 16777216, W2_WD = 16777216 + 46137344;

struct P {
  const float *x, *c, *ctx, *c_ctx, *w_ada, *b_ada, *n_pre_mix, *n_post_mix, *n_pre_ffn, *n_post_ffn, *w_in;
  const float *wg_f, *bg_f, *wg_b, *bg_b, *gla_norm, *short_w, *short_b, *emb_w, *emb_b, *mlp_w, *mlp_b, *freq, *out_w, *skip;
  const float *p_gla, *p_hy, *w_out, *ffn_gate, *ffn_up, *ffn_down;
  float* out; char* ws;
};

extern __shared__ __attribute__((aligned(16))) char g_smem[];

DI unsigned pk2(float lo, float hi) { f32x2 v = {lo, hi}; bfv2 r = __builtin_convertvector(v, bfv2); return __builtin_bit_cast(unsigned, r); }
DI bf16_t f2bf(float f) { __bf16 h = (__bf16)f; return __builtin_bit_cast(bf16_t, h); }
DI float bf2f(bf16_t h) { return __uint_as_float(((unsigned)h) << 16); }
DI float bflo(unsigned u) { return __uint_as_float(u << 16); }
DI float bfhi(unsigned u) { return __uint_as_float(u & 0xffff0000u); }
DI float wave_sum(float v) { for (int m = 32; m >= 1; m >>= 1) v += __shfl_xor(v, m, 64); return v; }
DI float sigmoidf_(float v) { return __builtin_amdgcn_rcpf(1.f + __expf(-v)); }
#define MFMA16(a, b, c) __builtin_amdgcn_mfma_f32_16x16x32_bf16((a), (b), (c), 0, 0, 0)
#define MFMA32(a, b, c) __builtin_amdgcn_mfma_f32_32x32x16_bf16((a), (b), (c), 0, 0, 0)

DI void wconv(const float* __restrict__ src, int ld, int K, int col0, int ncols, bf16_t* __restrict__ dst, int dstld, int drow0, int mode, int bid, int nb) {
  float* t = (float*)g_smem;
  const int tid = threadIdx.x;
  if ((ncols & 63) == 0) {
    const int ntn = ncols / 64, ntk = K / 64, nt = ntn * ntk;
    for (int it = bid; it < nt; it += nb) {
      const int tn = it % ntn, tk = it / ntn;
#pragma unroll
      for (int q = 0; q < 8; ++q) { int e = tid + 512 * q; int r = e >> 6, c = e & 63; t[r * 65 + c] = src[(size_t)(tk * 64 + r) * ld + col0 + tn * 64 + c]; }
      __syncthreads();
      { int n = tid >> 3, kk = (tid & 7) * 8; int cs = tn * 64 + n;
        int drow = mode == 0 ? drow0 + cs : ((cs >> 7) * 256 + drow0 + (cs & 127));
        u32x4 v; v.x = pk2(t[(kk) * 65 + n], t[(kk + 1) * 65 + n]); v.y = pk2(t[(kk + 2) * 65 + n], t[(kk + 3) * 65 + n]);
        v.z = pk2(t[(kk + 4) * 65 + n], t[(kk + 5) * 65 + n]); v.w = pk2(t[(kk + 6) * 65 + n], t[(kk + 7) * 65 + n]);
        *(u32x4*)(dst + (size_t)drow * dstld + tk * 64 + kk) = v; }
      __syncthreads();
    }
    return;
  }
  const int ntn = ncols / 32, ntk = K / 64, nt = ntn * ntk;
  for (int it = bid; it < nt; it += nb) {
    const int tn = it % ntn, tk = it / ntn;
#pragma unroll
    for (int q = 0; q < 4; ++q) { int e = tid + 512 * q; int r = e >> 5, c = e & 31; t[r * 33 + c] = src[(size_t)(tk * 64 + r) * ld + col0 + tn * 32 + c]; }
    __syncthreads();
    { int n = tid >> 4, kk = (tid & 15) * 4; int cs = tn * 32 + n;
      int drow = mode == 0 ? drow0 + cs : ((cs >> 7) * 256 + drow0 + (cs & 127));
      u32x2 v; v.x = pk2(t[(kk) * 33 + n], t[(kk + 1) * 33 + n]); v.y = pk2(t[(kk + 2) * 33 + n], t[(kk + 3) * 33 + n]);
      *(u32x2*)(dst + (size_t)drow * dstld + tk * 64 + kk) = v; }
    __syncthreads();
  }
}

DI void phase_prep(const P& p, int bid, int nb) {
  const int tid = threadIdx.x;
  {
    float* sl = (float*)(g_smem + 16384); float* red = sl + 3 * 2048;
    float* MOD = (float*)(p.ws + OFF_MOD);
    for (int it = bid; it < 192; it += nb) {
      for (int e = tid; e < 3 * 2048; e += 512) { int r = e >> 11, k = e & 2047; float v = r < 2 ? p.c[r * 2048 + k] : p.c_ctx[k]; sl[e] = v / (1.f + __expf(-v)); }
      __syncthreads();
      const int cgp = tid & 15, kg = tid >> 4; const int n0 = it * 64 + cgp * 4;
      f32x4 a0 = {0, 0, 0, 0}, a1 = a0, a2 = a0;
#pragma unroll 8
      for (int kk = 0; kk < 64; ++kk) { int k = kg * 64 + kk; f32x4 w = *(const f32x4*)(p.w_ada + (size_t)k * 12288 + n0); a0 += w * sl[k]; a1 += w * sl[2048 + k]; a2 += w * sl[4096 + k]; }
      *(f32x4*)(red + (kg * 3 + 0) * 64 + cgp * 4) = a0; *(f32x4*)(red + (kg * 3 + 1) * 64 + cgp * 4) = a1; *(f32x4*)(red + (kg * 3 + 2) * 64 + cgp * 4) = a2;
      __syncthreads();
      if (tid < 192) { int r = tid >> 6, c = tid & 63; float s = p.b_ada[it * 64 + c];
#pragma unroll 8
        for (int k2 = 0; k2 < 32; ++k2) s += red[(k2 * 3 + r) * 64 + c]; MOD[r * 12288 + it * 64 + c] = s; }
      __syncthreads();
    }
  }
  {
    float* zb = (float*)(g_smem + 16384); float* ha = zb + 8 * 36; float* hb = ha + 8 * 64;
    bf16_t* HDN = (bf16_t*)(p.ws + OFF_HDN);
    const int tl = tid >> 6, j = tid & 63;
    for (int it = bid; it < 2048; it += nb) {
      const int t = it * 8 + tl;
      if (j < 33) { float v; if (j == 0) v = (float)t * (1.f / 16383.f); else { int i = (j - 1) & 15; float fr = 1e-4f + (float)i * ((15.f - 1e-4f) / 15.f); float turns = fr * ((float)t * (1.f / 16384.f)); turns -= floorf(turns);
          v = (j <= 16) ? __builtin_amdgcn_cosf(turns) : -__builtin_amdgcn_sinf(turns); } zb[tl * 36 + j] = v; }
      __syncthreads();
      float acc = p.emb_b[j];
#pragma unroll 3
      for (int i = 0; i < 33; ++i) acc += zb[tl * 36 + i] * p.emb_w[i * 64 + j];
      ha[tl * 64 + j] = __sinf(p.freq[j] * acc);
      __syncthreads();
      acc = p.mlp_b[j];
#pragma unroll 8
      for (int i = 0; i < 64; ++i) acc += ha[tl * 64 + i] * p.mlp_w[i * 64 + j];
      hb[tl * 64 + j] = __sinf(p.freq[64 + j] * acc);
      __syncthreads();
      acc = p.mlp_b[64 + j];
#pragma unroll 8
      for (int i = 0; i < 64; ++i) acc += hb[tl * 64 + i] * p.mlp_w[4096 + i * 64 + j];
      HDN[(size_t)t * 64 + j] = f2bf(__sinf(p.freq[128 + j] * acc));
      __syncthreads();
    }
  }
}

DI void phase_pre(const P& p, int bid, int nb) {
  const int tid = threadIdx.x, wid = tid >> 6, lane = tid & 63;
  const float* MOD = (const float*)(p.ws + OFF_MOD);
  bf16_t* HX = (bf16_t*)(p.ws + OFF_HX);
  for (int row = bid * 8 + wid; row < TC; row += nb * 8) {
    const float* src; int mrow;
    if (row < T) { src = p.x + (size_t)row * D; mrow = row >> 14; } else { src = p.ctx + (size_t)(row - T) * D; mrow = 2; }
    f32x4 v[8]; float ss = 0.f;
#pragma unroll
    for (int q = 0; q < 8; ++q) { v[q] = *(const f32x4*)(src + q * 256 + lane * 4); ss += v[q].x * v[q].x + v[q].y * v[q].y + v[q].z * v[q].z + v[q].w * v[q].w; }
    ss = wave_sum(ss); const float rstd = rsqrtf(ss * (1.f / 2048.f) + 1e-6f);
    const float* sh = MOD + mrow * 12288; const float* sc = sh + 2048;
#pragma unroll
    for (int q = 0; q < 8; ++q) { int idx = q * 256 + lane * 4; f32x4 w = *(const f32x4*)(p.n_pre_mix + idx), s1 = *(const f32x4*)(sc + idx), h1 = *(const f32x4*)(sh + idx);
      f32x4 y = v[q] * rstd * w * (1.f + s1) + h1; u32x2 o; o.x = pk2(y.x, y.y); o.y = pk2(y.z, y.w); *(u32x2*)(HX + (size_t)row * D + idx) = o; }
  }
  {
    const int fr = lane & 15, fq = lane >> 4;
    const bf16_t* HDN = (const bf16_t*)(p.ws + OFF_HDN); float* HT = (float*)(p.ws + OFF_HT);
    for (int id = bid * 8 + wid; id < 128 * 64; id += nb * 8) {
      const int mt = id & 127, ng = id >> 7; const int ch = mt * 16 + fr;
      bf16x8 a[2];
#pragma unroll
      for (int s = 0; s < 2; ++s)
#pragma unroll
        for (int i = 0; i < 8; ++i) a[s][i] = (short)f2bf(p.out_w[(size_t)(s * 32 + fq * 8 + i) * 2048 + ch]);
      const float lo = -120.39728043259361f, hi = 40.546510810816436f;
      const float delta = fabsf(lo + (float)(ch & 1023) * ((hi - lo) / 1023.f));
      for (int q = 0; q < 16; ++q) {
        const int n0 = (ng * 16 + q) * 16;
        bf16x8 b0 = *(const bf16x8*)(HDN + (size_t)(n0 + fr) * 64 + fq * 8), b1 = *(const bf16x8*)(HDN + (size_t)(n0 + fr) * 64 + 32 + fq * 8);
        f32x4 acc = {0, 0, 0, 0};
        acc = MFMA16(b0, a[0], acc); acc = MFMA16(b1, a[1], acc);
#pragma unroll
        for (int jj = 0; jj < 4; ++jj) { float tl = (float)(n0 + 4 * fq + jj) * (1.f / 16383.f); acc[jj] *= __expf(-tl * delta); }
        *(f32x4*)(HT + (size_t)ch * 16384 + n0 + 4 * fq) = acc;
      }
    }
  }
  bf16_t* WIN = (bf16_t*)(p.ws + OFF_WIN);
#pragma unroll 1
  for (int job = 0; job < 7; ++job) {
    int col0, ncols, drow0, mode = 0;
    switch (job) { case 0: col0 = 0; ncols = 2048; drow0 = 0; break; case 1: col0 = 2080; ncols = 1024; drow0 = 2048; break;
      case 2: col0 = 3104; ncols = 1024; drow0 = 3072; break;
      case 3: col0 = 4128; ncols = 1024; drow0 = 4096; mode = 1; break;
      case 4: col0 = 5152; ncols = 1024; drow0 = 4096 + 128; mode = 1; break;
      case 5: col0 = 6176; ncols = 4096; drow0 = 6144; break; default: col0 = 2048; ncols = 32; drow0 = 10240; break; }
    wconv(p.w_in, 10272, 2048, col0, ncols, WIN, 2048, drow0, mode, bid, nb);
  }
  for (size_t e = (size_t)bid * 512 + tid; e < (size_t)224 * 2048 / 8; e += (size_t)nb * 512) ((u32x4*)(WIN + (size_t)10272 * 2048))[e] = (u32x4){0u, 0u, 0u, 0u};
}

DI int lds_byte(int r, int c) { int st = (r >> 4) * 2 + (c >> 5), rr = r & 15, cc = c & 31, ob = rr * 64 + cc * 2; return st * 1024 + (ob ^ (((ob >> 9) & 1) << 5)); }
DI void stage_rc(int b, int& R, int& C) { int st = b / 1024, sb = b % 1024, swz = sb ^ (((sb >> 9) & 1) << 5); R = (st >> 1) * 16 + swz / 64; C = (st & 1) * 32 + (swz % 64) / 2; }
DI int perm32(int rho) { const int n = rho >> 4, i = rho & 15; return 8 * (i >> 2) + 4 * n + (i & 3); }
DI void unit_order(int L, int nM, int nN, int& pm, int& pn) {
  const int nwg = nM * nN; int wgid = L;
  { const int q = nwg / 8, r = nwg % 8, xcd = wgid % 8, off = wgid / 8; wgid = (xcd < r ? xcd * (q + 1) : r * (q + 1) + (xcd - r) * q) + off; }
  const int nig = 8 * nN, gid = wgid / nig, fm = gid * 8, gsz = (nM - fm) < 8 ? (nM - fm) : 8;
  pm = fm + ((wgid % nig) % gsz); pn = (wgid % nig) / gsz;
}

struct Unit { const char* a; const char* b; int pm, pn, tag; };
template <class Sched, class Epi>
DI void gemm_stream(const long lda, const long ldb, const int K, const Sched& S, const Epi& E) {
  LAS unsigned char* lds = (LAS unsigned char*)g_smem;
  constexpr int HTB = 128 * 64 * 2;
  const int tid = threadIdx.x, wid = __builtin_amdgcn_readfirstlane(tid >> 6), lane = tid & 63, wr = wid >> 2, wc = wid & 3, fr = lane & 15, fq = lane >> 4;
  const int nt = K / 64;
  unsigned voffA[2], voffB[2];
#pragma unroll
  for (int i = 0; i < 2; ++i) { int R, C; stage_rc(tid * 16 + i * 8192, R, C); const int Rb = (R & ~31) + perm32(R & 31);
    voffA[i] = (unsigned)(R * (int)lda + C) * 2u; voffB[i] = (unsigned)(Rb * (int)ldb + C) * 2u; }
  const size_t kstep = 128, hstepA = (size_t)128 * lda * 2, hstepB = (size_t)128 * ldb * 2;
  const unsigned ldsw = (unsigned)wid * 1024u;
  const int aoff = lds_byte(wr * 64 + fr, fq * 8), boff = lds_byte(wc * 32 + fr, fq * 8);
#define G_SA(b, h) (((b) * 2 + (h)) * HTB)
#define G_SB(b, h) ((4 + (b) * 2 + (h)) * HTB)
#define G_STAGE(bufoff, gbase, voff) do { _Pragma("unroll") for (int _i = 0; _i < 2; ++_i) \
    __builtin_amdgcn_global_load_lds((const unsigned*)((const char*)(gbase) + (voff)[_i]), (LAS unsigned*)(lds + (bufoff) + ldsw + _i * 8192), 16, 0, 0); } while (0)
#define G_LDA(dst, b, h) do { _Pragma("unroll") for (int m = 0; m < 4; ++m) _Pragma("unroll") for (int k = 0; k < 2; ++k) dst[m][k] = *(const LAS bf16x8*)(lds + G_SA(b, h) + aoff + m * 2048 + k * 1024); } while (0)
#define G_LDB(dst, b, h) do { _Pragma("unroll") for (int n = 0; n < 2; ++n) _Pragma("unroll") for (int k = 0; k < 2; ++k) dst[n][k] = *(const LAS bf16x8*)(lds + G_SB(b, h) + boff + n * 2048 + k * 1024); } while (0)
#define G_MMA(ai, bj, At_, Bt_) do { __builtin_amdgcn_s_setprio(1); _Pragma("unroll") for (int m = 0; m < 4; ++m) _Pragma("unroll") for (int n = 0; n < 2; ++n) _Pragma("unroll") for (int k = 0; k < 2; ++k) \
    acc[ai][bj][m][n] = MFMA16(Bt_[n][k], At_[m][k], acc[ai][bj][m][n]); __builtin_amdgcn_s_setprio(0); } while (0)
#define G_WAIT_V(n) asm volatile("s_waitcnt vmcnt(" #n ")" ::: "memory")
#define G_WAIT_L(n) asm volatile("s_waitcnt lgkmcnt(" #n ")" ::: "memory")
#define G_BAR __builtin_amdgcn_s_barrier()
#define G_SCHED __builtin_amdgcn_sched_barrier(0)
  Unit cur, nxt; int ui = 0;
  if (!S.next(0, cur)) return;
  f32x4 acc[2][2][4][2];
#pragma unroll
  for (int a = 0; a < 2; ++a)
#pragma unroll
    for (int b = 0; b < 2; ++b)
#pragma unroll
      for (int m = 0; m < 4; ++m)
#pragma unroll
        for (int n = 0; n < 2; ++n) acc[a][b][m][n] = (f32x4){0.f, 0.f, 0.f, 0.f};
  bf16x8 At[4][2], B0[2][2], B1[2][2];
  const char* cA = cur.a; const char* cB = cur.b;
  G_WAIT_V(0);
  G_STAGE(G_SB(0, 0), cB, voffB); G_STAGE(G_SA(0, 0), cA, voffA); G_STAGE(G_SB(0, 1), cB + hstepB, voffB); G_STAGE(G_SA(0, 1), cA + hstepA, voffA);
  if (wr == 1) G_BAR;
  G_WAIT_V(4); G_BAR;
  G_STAGE(G_SB(1, 0), cB + kstep, voffB); G_STAGE(G_SA(1, 0), cA + kstep, voffA); G_STAGE(G_SB(1, 1), cB + hstepB + kstep, voffB);
  G_WAIT_V(6); G_BAR;
  for (;;) {
    const bool has_next = S.next(ui + 1, nxt);
    const char* nA = has_next ? nxt.a : cA; const char* nB = has_next ? nxt.b : cB;
#pragma unroll 1
    for (int t = 0; t < nt; t += 2) {
      const bool last = (t == nt - 2);
      const char* a1 = cA + (size_t)(t + 1) * kstep;
      const char* a2 = last ? nA : cA + (size_t)(t + 2) * kstep; const char* b2 = last ? nB : cB + (size_t)(t + 2) * kstep;
      const char* a3 = a2 + kstep; const char* b3 = b2 + kstep;
      G_LDB(B0, 0, 0); G_SCHED; G_LDA(At, 0, 0); G_STAGE(G_SA(1, 1), a1 + hstepA, voffA);
      G_WAIT_L(8); G_BAR; G_WAIT_L(0); G_MMA(0, 0, At, B0); G_BAR; G_SCHED;
      G_LDB(B1, 0, 1); G_STAGE(G_SB(0, 0), b2, voffB);
      G_BAR; G_WAIT_L(0); G_MMA(0, 1, At, B1); G_BAR;
      G_LDA(At, 0, 1); G_STAGE(G_SA(0, 0), a2, voffA);
      G_BAR; G_WAIT_L(0); G_MMA(1, 0, At, B0); G_BAR; G_SCHED;
      G_STAGE(G_SB(0, 1), b2 + hstepB, voffB);
      G_WAIT_V(6); G_BAR; G_MMA(1, 1, At, B1); G_BAR;
      G_LDB(B0, 1, 0); G_SCHED; G_LDA(At, 1, 0); G_STAGE(G_SA(0, 1), a2 + hstepA, voffA);
      G_WAIT_L(8); G_BAR; G_WAIT_L(0); G_MMA(0, 0, At, B0); G_BAR; G_SCHED;
      G_LDB(B1, 1, 1); G_STAGE(G_SB(1, 0), b3, voffB);
      G_BAR; G_WAIT_L(0); G_MMA(0, 1, At, B1); G_BAR;
      G_LDA(At, 1, 1); G_STAGE(G_SA(1, 0), a3, voffA);
      G_BAR; G_WAIT_L(0); G_MMA(1, 0, At, B0); G_BAR; G_SCHED;
      G_STAGE(G_SB(1, 1), b3 + hstepB, voffB);
      G_WAIT_V(6); G_BAR; G_MMA(1, 1, At, B1); G_BAR;
    }
    E(acc, cur, wr, wc, fr, fq);
    if (!has_next) break;
    if (!(nxt.tag & 1)) {
#pragma unroll
      for (int a = 0; a < 2; ++a)
#pragma unroll
        for (int b = 0; b < 2; ++b)
#pragma unroll
          for (int m = 0; m < 4; ++m)
#pragma unroll
            for (int n = 0; n < 2; ++n) acc[a][b][m][n] = (f32x4){0.f, 0.f, 0.f, 0.f};
    }
    cur = nxt; cA = nA; cB = nB; ++ui;
  }
  G_WAIT_V(0);
  if (wr == 0) G_BAR;
  G_BAR;
}

struct GridSched {
  const bf16_t* A; const bf16_t* Bt; long lda, ldb; int nM, nN, bid, nb;
  DI bool next(int i, Unit& u) const { const int L = i * nb + bid; if (L >= nM * nN) return false; unit_order(L, nM, nN, u.pm, u.pn);
    u.a = (const char*)(A + (size_t)u.pm * 256 * lda); u.b = (const char*)(Bt + (size_t)u.pn * 256 * ldb); u.tag = 0; return true; }
};

DI void zero_acc(f32x4 (&acc)[2][2][4][2]) {
#pragma unroll
  for (int a = 0; a < 2; ++a)
#pragma unroll
    for (int b = 0; b < 2; ++b)
#pragma unroll
      for (int m = 0; m < 4; ++m)
#pragma unroll
        for (int n = 0; n < 2; ++n) acc[a][b][m][n] = (f32x4){0.f, 0.f, 0.f, 0.f};
}

template <int ACT>
DI void store_tile_bf16(const f32x4 (&acc)[2][2][4][2], bf16_t* dst, long ld, int brow, int col0, float scale, int wr, int wc, int fr, int fq) {
#pragma unroll
  for (int ai = 0; ai < 2; ++ai)
#pragma unroll
    for (int m = 0; m < 4; ++m) {
      bf16_t* rp = dst + (long)(brow + ai * 128 + wr * 64 + m * 16 + fr) * ld + col0 + wc * 32 + 8 * fq;
#pragma unroll
      for (int bj = 0; bj < 2; ++bj) {
        f32x4 v0 = acc[ai][bj][m][0], v1 = acc[ai][bj][m][1];
        if (ACT == 1) { v0 *= scale; v1 *= scale; }
        if (ACT == 2) {
#pragma unroll
          for (int j = 0; j < 4; ++j) { v0[j] = v0[j] * sigmoidf_(v0[j]); v1[j] = v1[j] * sigmoidf_(v1[j]); } }
        u32x4 w; w.x = pk2(v0[0], v0[1]); w.y = pk2(v0[2], v0[3]); w.z = pk2(v1[0], v1[1]); w.w = pk2(v1[2], v1[3]);
        *(u32x4*)(rp + bj * 128) = w;
      }
    }
}

struct Gemm1Sched { const bf16_t* A; const bf16_t* Bt; int bid, nb;
  DI bool next(int i, Unit& u) const { const int L = i * nb + bid; const int nmain = 128 * 41; if (L >= nmain + 18) return false;
    if (L < nmain) unit_order(L, 128, 41, u.pm, u.pn); else { int e = L - nmain; u.pm = 128 + e / 9; int c = e % 9; u.pn = c < 8 ? c : 40; }
    u.a = (const char*)(A + (size_t)u.pm * 256 * 2048); u.b = (const char*)(Bt + (size_t)u.pn * 256 * 2048); u.tag = 0; return true; } };
DI void phase_gemm1(const P& p, int bid, int nb) {
  const bf16_t* HX = (const bf16_t*)(p.ws + OFF_HX); const bf16_t* WIN = (const bf16_t*)(p.ws + OFF_WIN);
  bf16_t* QKV = (bf16_t*)(p.ws + OFF_QKV); bf16_t* G = (bf16_t*)(p.ws + OFF_G); bf16_t* ZH = (bf16_t*)(p.ws + OFF_ZH); bf16_t* MG = (bf16_t*)p.out;
  float* LR = (float*)(p.ws + OFF_LR);
  Gemm1Sched S{HX, WIN, bid, nb};
  auto E = [&](f32x4 (&acc)[2][2][4][2], const Unit& u, int wr, int wc, int fr, int fq) {
    const int brow = u.pm * 256, pn = u.pn;
    if (pn < 2) store_tile_bf16<1>(acc, QKV, 2048, brow, pn * 256, 0.08838834764831845f, wr, wc, fr, fq);
    else if (pn < 8) store_tile_bf16<0>(acc, QKV, 2048, brow, pn * 256, 1.f, wr, wc, fr, fq);
    else if (pn < 12) store_tile_bf16<2>(acc, G, 1024, brow, (pn - 8) * 256, 1.f, wr, wc, fr, fq);
    else if (pn < 16) store_tile_bf16<0>(acc, ZH, 1024, brow, (pn - 12) * 256, 1.f, wr, wc, fr, fq);
    else if (pn < 24) {
      const int lane = threadIdx.x & 63; const int cb = (pn - 16) * 128 + wc * 32 + 8 * fq;
      const int upsrc = (lane & ~15) | ((fr - 1) & 15), dnsrc = (lane & ~15) | ((fr + 1) & 15);
      float* ZCf = (float*)(p.ws + OFF_ZC);
      f32x4 wx[4][2], wv[4][2];
#pragma unroll
      for (int q = 0; q < 2; ++q) {
#pragma unroll
        for (int tp = 0; tp < 3; ++tp) { wx[tp][q] = *(const f32x4*)(p.short_w + tp * 3072 + 1024 + cb + 4 * q); wv[tp][q] = *(const f32x4*)(p.short_w + tp * 3072 + 2048 + cb + 4 * q); }
        wx[3][q] = *(const f32x4*)(p.short_b + 1024 + cb + 4 * q); wv[3][q] = *(const f32x4*)(p.short_b + 2048 + cb + 4 * q); }
      __builtin_amdgcn_sched_barrier(0);
#pragma unroll
      for (int n = 0; n < 2; ++n)
#pragma unroll
        for (int jj = 0; jj < 4; ++jj) { const int c = cb + 4 * n + jj;
          const float a0 = wx[0][n][jj], a1 = wx[1][n][jj], a2 = wx[2][n][jj], ab = wx[3][n][jj];
          const float v0 = wv[0][n][jj], v1 = wv[1][n][jj], v2 = wv[2][n][jj], vbias = wv[3][n][jj];
#pragma unroll
          for (int ai = 0; ai < 2; ++ai) { const int t0 = brow + ai * 128 + wr * 64; const int bb = t0 >> 14, tin = t0 & 16383;
            float xr[4], vr[4], xu[4], vu[4], xd[4], vd[4];
#pragma unroll
            for (int m = 0; m < 4; ++m) { xr[m] = acc[ai][0][m][n][jj]; vr[m] = acc[ai][1][m][n][jj];
              xu[m] = __shfl(xr[m], upsrc, 64); vu[m] = __shfl(vr[m], upsrc, 64); xd[m] = __shfl(xr[m], dnsrc, 64); vd[m] = __shfl(vr[m], dnsrc, 64); }
            float* zp = ZCf + ((size_t)bb * 1024 + c) * 16384 + tin + fr;
#pragma unroll
            for (int m = 0; m < 4; ++m) {
              const float xup = fr > 0 ? xu[m] : (m > 0 ? xu[m - 1] : 0.f), vup = fr > 0 ? vu[m] : (m > 0 ? vu[m - 1] : 0.f);
              const float xdn = fr < 15 ? xd[m] : (m < 3 ? xd[m + 1] : 0.f), vdn = fr < 15 ? vd[m] : (m < 3 ? vd[m + 1] : 0.f);
              const float ux = a0 * xup + a1 * xr[m] + a2 * xdn + ab, uv = v0 * vup + v1 * vr[m] + v2 * vdn + vbias;
              zp[16 * m] = ux * uv; } } }
    }
    else if (pn < 40) store_tile_bf16<0>(acc, MG, 4096, brow, (pn - 24) * 256, 1.f, wr, wc, fr, fq);
    else if (wc == 0) {
#pragma unroll
      for (int ai = 0; ai < 2; ++ai)
#pragma unroll
        for (int m = 0; m < 4; ++m) { float* rp = LR + (size_t)(brow + ai * 128 + wr * 64 + m * 16 + fr) * 32 + 8 * fq;
          *(f32x4*)(rp) = acc[ai][0][m][0]; *(f32x4*)(rp + 4) = acc[ai][0][m][1]; }
    }
  };
  gemm_stream(2048, 2048, 2048, S, E);
}

DI void phase_local(const P& p, int bid, int nb) {
  const int tid = threadIdx.x, wid = tid >> 6, lane = tid & 63, fr = lane & 15, fq = lane >> 4;
  float* bL = (float*)g_smem;
  bf16_t* Qs = (bf16_t*)(g_smem + 33280);
  bf16_t* Ks = Qs + 64 * 136;
  bf16_t* KT = Ks + 64 * 136;
  bf16_t* Pm = KT + 128 * 72;
  bf16_t* VTl = Pm + 64 * 136;
  float* tot = (float*)(VTl + 256 * 72);
  float* wgL = (float*)KT;
  const bf16_t* QKV = (const bf16_t*)(p.ws + OFF_QKV); const float* LR = (const float*)(p.ws + OFF_LR);
  bf16_t* QI = (bf16_t*)(p.ws + OFF_QI); bf16_t* KST = (bf16_t*)(p.ws + OFF_KST); bf16_t* VT = (bf16_t*)(p.ws + OFF_VT);
  float* DD = (float*)(p.ws + OFF_DD); bf16_t* O = (bf16_t*)(p.ws + OFF_O);
  for (int u = bid; u < 2080; u += nb) {
    int b, n, hd; size_t row0; const bool isctx = u >= 2048;
    if (!isctx) { hd = u & 3; n = (u >> 2) & 255; b = u >> 10; row0 = (size_t)b * 16384 + n * 64; }
    else { int v = u - 2048; hd = v & 3; n = (v >> 2) & 3; b = v >> 4; row0 = (size_t)T + b * 256 + n * 64; }
    { const bf16_t* vp = QKV + (row0 + lane) * 2048 + 1024 + hd * 256 + wid * 32;
#pragma unroll
      for (int q = 0; q < 4; ++q) { bf16x8 v = *(const bf16x8*)(vp + q * 8);
#pragma unroll
        for (int e = 0; e < 8; ++e) VTl[(wid * 32 + q * 8 + e) * 72 + lane] = (bf16_t)v[e]; } }
    for (int dir = 0; dir < 2; ++dir) {
      { const float* wg = dir ? p.wg_b : p.wg_f; const float* bg = dir ? p.bg_b : p.bg_f;
        *(f32x4*)(wgL + (tid >> 5) * 128 + (tid & 31) * 4) = *(const f32x4*)(wg + (tid >> 5) * 512 + hd * 128 + (tid & 31) * 4);
        if (tid < 128) wgL[2048 + tid] = bg[hd * 128 + tid]; }
      __syncthreads();
      { const float* lr = LR + (row0 + lane) * 32 + dir * 16;
        f32x4 l0 = *(const f32x4*)(lr), l1 = *(const f32x4*)(lr + 4), l2 = *(const f32x4*)(lr + 8), l3 = *(const f32x4*)(lr + 12);
        const float lv[16] = {l0.x, l0.y, l0.z, l0.w, l1.x, l1.y, l1.z, l1.w, l2.x, l2.y, l2.z, l2.w, l3.x, l3.y, l3.z, l3.w};
        f32x4 z4[4];
#pragma unroll
        for (int q = 0; q < 4; ++q) z4[q] = *(const f32x4*)(wgL + 2048 + wid * 16 + 4 * q);
#pragma unroll
        for (int r = 0; r < 16; ++r)
#pragma unroll
          for (int q = 0; q < 4; ++q) z4[q] += *(const f32x4*)(wgL + r * 128 + wid * 16 + 4 * q) * lv[r];
#pragma unroll
        for (int e = 0; e < 16; ++e) { const float z = z4[e >> 2][e & 3];
          bL[lane * 129 + wid * 16 + e] = (fminf(z, 0.f) - __logf(1.f + __expf(-fabsf(z)))) * (1.f / 16.f); } }
      __syncthreads();
      { const int col = tid & 127, seg = tid >> 7; float a = 0.f;
#pragma unroll
        for (int i = 0; i < 16; ++i) { const int row = dir ? (seg * 16 + 15 - i) : (seg * 16 + i); a += bL[row * 129 + col]; bL[row * 129 + col] = a; }
        tot[seg * 128 + col] = a; }
      __syncthreads();
      { const int col = tid & 127, seg = tid >> 7; float off = 0.f;
#pragma unroll
        for (int s2 = 0; s2 < 4; ++s2) { const bool use = dir ? (s2 > seg) : (s2 < seg); if (use) off += tot[s2 * 128 + col]; }
#pragma unroll
        for (int i = 0; i < 16; ++i) bL[(seg * 16 + i) * 129 + col] += off; }
      __syncthreads();
      { const int j = lane;
        const bf16_t* qp = QKV + (row0 + j) * 2048 + hd * 128 + wid * 16; const bf16_t* kp = qp + 512;
        bf16x8 q0 = *(const bf16x8*)qp, q1 = *(const bf16x8*)(qp + 8), k0 = *(const bf16x8*)kp, k1 = *(const bf16x8*)(kp + 8);
        const int jref = dir ? 32 : 31, jlast = dir ? 0 : 63;
        float qiv[16], qsv[16], ksv[16];
#pragma unroll
        for (int e = 0; e < 16; ++e) { const int dk = wid * 16 + e; float bq = bL[j * 129 + dk], br = bL[jref * 129 + dk], bl = bL[jlast * 129 + dk];
          float qv = bf2f((bf16_t)(e < 8 ? q0[e & 7] : q1[e & 7])), kv = bf2f((bf16_t)(e < 8 ? k0[e & 7] : k1[e & 7]));
          qsv[e] = qv * __expf(bq - br); ksv[e] = kv * __expf(br - bq);
          qiv[e] = qv * __expf(bq); KT[dk * 72 + j] = f2bf(kv * __expf(bl - bq));
          if (j == jlast) DD[((size_t)u * 2 + dir) * 128 + dk] = __expf(bl); }
        u32x4 w0, w1;
        w0.x = pk2(qsv[0], qsv[1]); w0.y = pk2(qsv[2], qsv[3]); w0.z = pk2(qsv[4], qsv[5]); w0.w = pk2(qsv[6], qsv[7]);
        w1.x = pk2(qsv[8], qsv[9]); w1.y = pk2(qsv[10], qsv[11]); w1.z = pk2(qsv[12], qsv[13]); w1.w = pk2(qsv[14], qsv[15]);
        *(u32x4*)(Qs + j * 136 + wid * 16) = w0; *(u32x4*)(Qs + j * 136 + wid * 16 + 8) = w1;
        w0.x = pk2(ksv[0], ksv[1]); w0.y = pk2(ksv[2], ksv[3]); w0.z = pk2(ksv[4], ksv[5]); w0.w = pk2(ksv[6], ksv[7]);
        w1.x = pk2(ksv[8], ksv[9]); w1.y = pk2(ksv[10], ksv[11]); w1.z = pk2(ksv[12], ksv[13]); w1.w = pk2(ksv[14], ksv[15]);
        *(u32x4*)(Ks + j * 136 + wid * 16) = w0; *(u32x4*)(Ks + j * 136 + wid * 16 + 8) = w1;
        w0.x = pk2(qiv[0], qiv[1]); w0.y = pk2(qiv[2], qiv[3]); w0.z = pk2(qiv[8], qiv[9]); w0.w = pk2(qiv[10], qiv[11]);
        w1.x = pk2(qiv[4], qiv[5]); w1.y = pk2(qiv[6], qiv[7]); w1.z = pk2(qiv[12], qiv[13]); w1.w = pk2(qiv[14], qiv[15]);
        bf16_t* qo = QI + (((size_t)u * 2 + dir) * 64 + j) * 128 + wid * 16;
        *(u32x4*)qo = w0; *(u32x4*)(qo + 8) = w1; }
      __syncthreads();
      { const int ti = wid >> 1, tj0 = 2 * (wid & 1);
#pragma unroll
        for (int tt = 0; tt < 2; ++tt) { const int tj = tj0 + tt; f32x4 acc = {0, 0, 0, 0};
#pragma unroll
          for (int s = 0; s < 4; ++s) { bf16x8 a = *(const bf16x8*)(Qs + (16 * ti + fr) * 136 + 32 * s + 8 * fq), bb = *(const bf16x8*)(Ks + (16 * tj + fr) * 136 + 32 * s + 8 * fq);
            acc = MFMA16(bb, a, acc); }
          const int i = 16 * ti + fr;
#pragma unroll
          for (int jj = 0; jj < 4; ++jj) { int jc = 16 * tj + 4 * fq + jj; bool keep = dir ? (jc >= i) : (jc <= i); if (!keep) acc[jj] = 0.f; }
          u32x2 w; w.x = pk2(acc[0], acc[1]); w.y = pk2(acc[2], acc[3]);
          *(u32x2*)(Pm + i * 136 + dir * 64 + 16 * tj + 4 * fq) = w; }
        const int dk = tid >> 2, part = tid & 3;
        bf16_t* ko = KST + (((size_t)u * 2 + dir) * 128 + dk) * 64 + part * 16;
        *(u32x4*)ko = *(const u32x4*)(KT + dk * 72 + part * 16); *(u32x4*)(ko + 8) = *(const u32x4*)(KT + dk * 72 + part * 16 + 8); }
      __syncthreads();
    }
    { const int dv = tid >> 1, part = tid & 1; bf16_t* vo = VT + ((size_t)u * 256 + dv) * 64 + part * 32;
#pragma unroll
      for (int q = 0; q < 4; ++q) *(u32x4*)(vo + q * 8) = *(const u32x4*)(VTl + dv * 72 + part * 32 + q * 8); }
    if (!isctx) {
#pragma unroll
      for (int tt = 0; tt < 2; ++tt) { const int tn = 2 * wid + tt;
        bf16x8 bfv[4];
#pragma unroll
        for (int s = 0; s < 4; ++s) bfv[s] = *(const bf16x8*)(VTl + (16 * tn + fr) * 72 + ((32 * s + 8 * fq) & 63));
#pragma unroll
        for (int ti = 0; ti < 4; ++ti) { f32x4 acc = {0, 0, 0, 0};
#pragma unroll
          for (int s = 0; s < 4; ++s) { bf16x8 a = *(const bf16x8*)(Pm + (16 * ti + fr) * 136 + 32 * s + 8 * fq); acc = MFMA16(bfv[s], a, acc); }
          u32x2 w; w.x = pk2(acc[0], acc[1]); w.y = pk2(acc[2], acc[3]);
          *(u32x2*)(O + (row0 + 16 * ti + fr) * 1024 + hd * 256 + 16 * tn + 4 * fq) = w; } }
    }
    __syncthreads();
  }
}

DI int fpad(int n) { return n + (n >> 4); }
DI int otid() { int t = threadIdx.x; asm volatile("" : "+v"(t)); return t; }
DI f32x2 cmul(f32x2 a, f32x2 b) { return (f32x2){a.x * b.x - a.y * b.y, a.x * b.y + a.y * b.x}; }
DI f32x2 cmulc(f32x2 a, f32x2 b) { return (f32x2){a.x * b.x + a.y * b.y, a.y * b.x - a.x * b.y}; }
DI f32x2 twid(float frac) { return (f32x2){__builtin_amdgcn_cosf(frac), -__builtin_amdgcn_sinf(frac)}; }
template <bool INV> DI void dft4(f32x2& a, f32x2& b, f32x2& c, f32x2& d) {
  f32x2 s0 = a + c, s1 = a - c, s2 = b + d, s3 = b - d;
  f32x2 t = INV ? (f32x2){-s3.y, s3.x} : (f32x2){s3.y, -s3.x};
  a = s0 + s2; c = s0 - s2; b = s1 + t; d = s1 - t;
}
template <bool INV> DI void dft16(f32x2 (&x)[16]) {
  constexpr float CS[10] = {1.f, 0.9238795325112867f, 0.7071067811865476f, 0.3826834323650898f, 0.f, -0.3826834323650898f, -0.7071067811865476f, -0.9238795325112867f, -1.f, -0.9238795325112867f};
  constexpr float SN[10] = {0.f, 0.3826834323650898f, 0.7071067811865476f, 0.9238795325112867f, 1.f, 0.9238795325112867f, 0.7071067811865476f, 0.3826834323650898f, 0.f, -0.3826834323650898f};
#pragma unroll
  for (int a = 0; a < 4; ++a) dft4<INV>(x[a], x[a + 4], x[a + 8], x[a + 12]);
#pragma unroll
  for (int a = 1; a < 4; ++a)
#pragma unroll
    for (int c = 1; c < 4; ++c) { const int m = a * c; f32x2 w = {CS[m], INV ? SN[m] : -SN[m]}; x[a + 4 * c] = cmul(x[a + 4 * c], w); }
#pragma unroll
  for (int c = 0; c < 4; ++c) dft4<INV>(x[4 * c], x[4 * c + 1], x[4 * c + 2], x[4 * c + 3]);
}
#define OIDX(k) (4 * ((k) & 3) + ((k) >> 2))

DI void twpow(f32x2 w1, f32x2 (&w)[16]) {
  w[1] = w1; w[2] = cmul(w1, w1); w[4] = cmul(w[2], w[2]); w[8] = cmul(w[4], w[4]);
  w[3] = cmul(w[2], w[1]); w[5] = cmul(w[4], w[1]); w[6] = cmul(w[4], w[2]); w[7] = cmul(w[4], w[3]);
  w[9] = cmul(w[8], w[1]); w[10] = cmul(w[8], w[2]); w[11] = cmul(w[8], w[3]); w[12] = cmul(w[8], w[4]);
  w[13] = cmul(w[8], w[5]); w[14] = cmul(w[8], w[6]); w[15] = cmul(w[8], w[7]);
}
template <bool INV> DI void pass16(f32x2* X, int id, int ls) {
  const int s = 1 << ls, n0 = id & (s - 1), base = (id >> ls) << (ls + 4);
  f32x2 w[16]; twpow(twid((float)n0 / (float)(16 << ls)), w);
  f32x2 v[16];
  f32x2* Xb = X + fpad(base + n0); const int ps = s + (s >> 4);
#pragma unroll
  for (int k = 0; k < 16; ++k) v[k] = Xb[k * ps];
  if (INV) {
#pragma unroll
    for (int k = 1; k < 16; ++k) v[k] = cmulc(v[k], w[k]);
    dft16<true>(v);
#pragma unroll
    for (int k = 0; k < 16; ++k) Xb[k * ps] = v[OIDX(k)];
  } else {
    dft16<false>(v);
#pragma unroll
    for (int k = 0; k < 16; ++k) { f32x2 y = v[OIDX(k)]; if (k) y = cmul(y, w[k]); Xb[k * ps] = y; }
  }
}
DI void fft_fwd23(f32x2* X) {
  __syncthreads();
  { const int tid = otid();
#pragma unroll
  for (int q = 0; q < 2; ++q) pass16<false>(X, tid + 512 * q, 8); }
  __syncthreads();
  { const int tid = otid();
#pragma unroll
  for (int q = 0; q < 2; ++q) pass16<false>(X, tid + 512 * q, 4); }
  __syncthreads();
}
DI void f1_store(f32x2* X, int n0, f32x2 a, f32x2 b, f32x2 c, f32x2 d) {
  dft4<false>(a, b, c, d);
  f32x2 w1 = twid((float)n0 * (1.f / 16384.f)), w2 = cmul(w1, w1), w3 = cmul(w2, w1);
  f32x2* Xb = X + fpad(n0);
  Xb[0] = a; Xb[4352] = cmul(b, w1); Xb[8704] = cmul(c, w2); Xb[13056] = cmul(d, w3);
}

DI void fft_channel(const P& p, int c, f32x2* G1, f32x2* G2, f32x2* G3) {
  f32x2* X = (f32x2*)g_smem;
  const float* hf = (const float*)(p.ws + OFF_HT) + (size_t)c * 16384; const float* hb = hf + (size_t)1024 * 16384;
  float* zc0 = (float*)(p.ws + OFF_ZC) + (size_t)c * 16384; float* zc1 = zc0 + (size_t)1024 * 16384;
  const float skip = p.skip[c];
  const float R2 = 0.7071067811865476f;
#pragma unroll 1
  for (int rnd = 0; rnd < 2; ++rnd) {
#pragma unroll 1
    for (int q0 = 0; q0 < 8; q0 += 4) {
      const int tid = otid();
      float f[4][4], g[4][4];
#pragma unroll
      for (int qq = 0; qq < 4; ++qq)
#pragma unroll
        for (int jx = 0; jx < 4; ++jx) { const int n = tid + 512 * (q0 + qq) + 4096 * jx; f[qq][jx] = hf[n]; g[qq][jx] = n ? hb[16384 - n] : 0.f; }
#pragma unroll
      for (int qq = 0; qq < 4; ++qq) { const int n0 = tid + 512 * (q0 + qq); f32x2 v[4];
        if (rnd == 0) {
#pragma unroll
          for (int jx = 0; jx < 4; ++jx) v[jx] = (f32x2){f[qq][jx] + g[qq][jx], 0.f};
        } else { const f32x2 w0 = twid((float)n0 * (1.f / 32768.f));
          const f32x2 w1 = cmul(w0, (f32x2){R2, -R2}), w2 = (f32x2){w0.y, -w0.x}, w3 = cmul(w0, (f32x2){-R2, -R2});
          v[0] = w0 * (f[qq][0] - g[qq][0]); v[1] = w1 * (f[qq][1] - g[qq][1]); v[2] = w2 * (f[qq][2] - g[qq][2]); v[3] = w3 * (f[qq][3] - g[qq][3]); }
        f1_store(X, n0, v[0], v[1], v[2], v[3]); }
    }
    fft_fwd23(X);
    f32x2* Gk = rnd ? G2 : G1;
#pragma unroll 1
    for (int q = 0; q < 2; ++q) { const int id = otid() + 512 * q; f32x2 v[16];
#pragma unroll
      for (int k = 0; k < 16; ++k) v[k] = X[id * 17 + k];
      dft16<false>(v);
#pragma unroll
      for (int k = 0; k < 16; k += 2) { f32x2 a = v[OIDX(k)] * (1.f / 32768.f), b = v[OIDX(k + 1)] * (1.f / 32768.f); *(f32x4*)(Gk + id * 16 + k) = (f32x4){a.x, a.y, b.x, b.y}; } }
    __syncthreads();
  }
#pragma unroll 1
  for (int rnd = 0; rnd < 2; ++rnd) {
#pragma unroll 1
    for (int q0 = 0; q0 < 8; q0 += 4) {
      const int tid = otid();
      f32x2 z[4][4];
#pragma unroll
      for (int qq = 0; qq < 4; ++qq)
#pragma unroll
        for (int jx = 0; jx < 4; ++jx) { const int n = tid + 512 * (q0 + qq) + 4096 * jx; z[qq][jx] = (f32x2){zc0[n], zc1[n]}; }
#pragma unroll
      for (int qq = 0; qq < 4; ++qq) { const int n0 = tid + 512 * (q0 + qq);
        if (rnd) { const f32x2 w0 = twid((float)n0 * (1.f / 32768.f));
          const f32x2 w1 = cmul(w0, (f32x2){R2, -R2}), w2 = (f32x2){w0.y, -w0.x}, w3 = cmul(w0, (f32x2){-R2, -R2});
          z[qq][0] = cmul(z[qq][0], w0); z[qq][1] = cmul(z[qq][1], w1); z[qq][2] = cmul(z[qq][2], w2); z[qq][3] = cmul(z[qq][3], w3); }
        f1_store(X, n0, z[qq][0], z[qq][1], z[qq][2], z[qq][3]); }
    }
    fft_fwd23(X);
    const f32x2* Gk = rnd ? G2 : G1;
#pragma unroll 1
    for (int q = 0; q < 2; ++q) { const int id = otid() + 512 * q; f32x2 v[16], w[16];
      f32x4 kk[8];
#pragma unroll
      for (int k = 0; k < 8; ++k) kk[k] = *(const f32x4*)(Gk + id * 16 + 2 * k);
#pragma unroll
      for (int k = 0; k < 16; ++k) v[k] = X[id * 17 + k];
      dft16<false>(v);
#pragma unroll
      for (int k = 0; k < 16; k += 2) { w[k] = cmul(v[OIDX(k)], (f32x2){kk[k >> 1].x, kk[k >> 1].y}); w[k + 1] = cmul(v[OIDX(k + 1)], (f32x2){kk[k >> 1].z, kk[k >> 1].w}); }
      dft16<true>(w);
#pragma unroll
      for (int k = 0; k < 16; ++k) X[id * 17 + k] = w[OIDX(k)]; }
    __syncthreads();
    { const int tid = otid();
#pragma unroll
    for (int q = 0; q < 2; ++q) pass16<true>(X, tid + 512 * q, 4); }
    __syncthreads();
    { const int tid = otid();
#pragma unroll
    for (int q = 0; q < 2; ++q) pass16<true>(X, tid + 512 * q, 8); }
    __syncthreads();
#pragma unroll 1
    for (int q0 = 0; q0 < 8; q0 += 4) {
      const int tid = otid();
      f32x2 r1[4][4], zz[4][4];
      if (rnd) {
#pragma unroll
        for (int qq = 0; qq < 4; ++qq)
#pragma unroll
          for (int jx = 0; jx < 4; ++jx) { const int n = tid + 512 * (q0 + qq) + 4096 * jx; r1[qq][jx] = G3[n]; zz[qq][jx] = (f32x2){zc0[n], zc1[n]}; }
      }
#pragma unroll
      for (int qq = 0; qq < 4; ++qq) { const int n0 = tid + 512 * (q0 + qq);
        const f32x2 t1 = twid((float)n0 * (1.f / 16384.f)), t2 = cmul(t1, t1), t3 = cmul(t2, t1);
        f32x2 v[4];
        const f32x2* Xb = X + fpad(n0);
        v[0] = Xb[0]; v[1] = cmulc(Xb[4352], t1); v[2] = cmulc(Xb[8704], t2); v[3] = cmulc(Xb[13056], t3);
        dft4<true>(v[0], v[1], v[2], v[3]);
        if (rnd == 0) {
#pragma unroll
          for (int jx = 0; jx < 4; ++jx) G3[n0 + 4096 * jx] = v[jx];
        } else { const f32x2 w0 = twid((float)n0 * (1.f / 32768.f));
          const f32x2 wj[4] = {w0, cmul(w0, (f32x2){R2, -R2}), (f32x2){w0.y, -w0.x}, cmul(w0, (f32x2){-R2, -R2})};
#pragma unroll
          for (int jx = 0; jx < 4; ++jx) { f32x2 y = r1[qq][jx] + cmulc(v[jx], wj[jx]) + zz[qq][jx] * skip; zc0[n0 + 4096 * jx] = y.x; zc1[n0 + 4096 * jx] = y.y; } } }
    }
    __syncthreads();
  }
}

DI bf16x8 pack8(const f32x16& x, int s) {
  u32x4 r; r.x = pk2(x[8 * s], x[8 * s + 1]); r.y = pk2(x[8 * s + 2], x[8 * s + 3]); r.z = pk2(x[8 * s + 4], x[8 * s + 5]); r.w = pk2(x[8 * s + 6], x[8 * s + 7]);
  return __builtin_bit_cast(bf16x8, r);
}
constexpr int SEGLEN = 17, NSEG = 16;
DI void scan_step_addr(const P& p, int b, int hd, int dir, int step, bool& isctx, int& n, size_t& unit) {
  isctx = step < 4;
  if (isctx) { n = dir ? 3 - step : step; unit = 2048 + (size_t)(b * 4 + n) * 4 + hd; }
  else { int m = step - 4; n = dir ? 255 - m : m; unit = (size_t)(b * 256 + n) * 4 + hd; }
}
DI void scan_decay(f32x16 (&S)[4], float d0, float d1, int h2) {
#pragma unroll
  for (int a = 0; a < 4; ++a)
#pragma unroll
    for (int i = 0; i < 16; ++i) { const int src = 32 * (a & 1) + (i & 3) + 8 * (i >> 2) + 4 * h2; S[a][i] *= __shfl((a < 2) ? d0 : d1, src, 64); }
}
template <int V> struct IC { static constexpr int value = V; };
template <bool OUT>
DI void scan_segment(const P& p, f32x16 (&S)[4], int b, int hd, int dir, int s0, int s1, float& dp0, float& dp1) {
  const int tid = threadIdx.x, wid = tid >> 6, lane = tid & 63, r = lane & 31, h2 = lane >> 5;
  const bf16_t* QI = (const bf16_t*)(p.ws + OFF_QI); const bf16_t* KST = (const bf16_t*)(p.ws + OFF_KST); const bf16_t* VT = (const bf16_t*)(p.ws + OFF_VT);
  const float* DD = (const float*)(p.ws + OFF_DD); bf16_t* OFB = (bf16_t*)(p.ws + OFF_OFB);
  char* img = g_smem;
  bf16x8 kq[2][2], kk[2][2], vb[2][4]; float d0[2], d1[2];
  auto fetch = [&](int step, auto PP, bool with_v) {
    constexpr int Q = decltype(PP)::value;
    bool isctx; int n; size_t unit; scan_step_addr(p, b, hd, dir, step, isctx, n, unit);
    const bf16_t* qi = QI + (unit * 2 + dir) * 8192; const bf16_t* kst = KST + (unit * 2 + dir) * 8192; const float* dd = DD + (unit * 2 + dir) * 128;
    const bf16_t* vt = VT + unit * 16384 + (size_t)(wid * 32) * 64;
#pragma unroll
    for (int e = 0; e < 2; ++e) { const int f = 2 * wid + e;
      if (OUT) { const int m = f >> 3, a = (f >> 1) & 3, s = f & 1; kq[Q][e] = *(const bf16x8*)(qi + (32 * m + r) * 128 + a * 32 + s * 16 + h2 * 8); }
      { const int s = f >> 2, a = f & 3; kk[Q][e] = *(const bf16x8*)(kst + (32 * a + r) * 64 + s * 16 + h2 * 8); } }
    if (with_v) {
#pragma unroll
      for (int s = 0; s < 4; ++s) vb[Q][s] = *(const bf16x8*)(vt + r * 64 + s * 16 + h2 * 8); }
    d0[Q] = dd[lane]; d1[Q] = dd[64 + lane];
  };
  auto fetch_v = [&](int step, auto PP) {
    constexpr int Q = decltype(PP)::value;
    bool isctx; int n; size_t unit; scan_step_addr(p, b, hd, dir, step, isctx, n, unit);
    const bf16_t* vt = VT + unit * 16384 + (size_t)(wid * 32) * 64;
#pragma unroll
    for (int s = 0; s < 4; ++s) vb[Q][s] = *(const bf16x8*)(vt + r * 64 + s * 16 + h2 * 8);
  };
  auto body = [&](int step, auto PP) {
    constexpr int Q = decltype(PP)::value;
    char* ib = img + Q * 32768;
#pragma unroll
    for (int e = 0; e < 2; ++e) { const int f = 2 * wid + e;
      if (OUT) *(bf16x8*)(ib + f * 1024 + lane * 16) = kq[Q][e];
      *(bf16x8*)(ib + (16 + f) * 1024 + lane * 16) = kk[Q][e]; }
    const float c0 = d0[Q], c1 = d1[Q];
    bool isctx; int n; size_t unit; scan_step_addr(p, b, hd, dir, step, isctx, n, unit);
    __syncthreads();
    fetch(min(step + 2, s1 - 1), PP, false);
    if (OUT && !isctx) {
      f32x16 o0, o1;
#pragma unroll
      for (int i = 0; i < 16; ++i) { o0[i] = 0.f; o1[i] = 0.f; }
#pragma unroll
      for (int a = 0; a < 4; ++a)
#pragma unroll
        for (int s = 0; s < 2; ++s) { bf16x8 sb = pack8(S[a], s);
          bf16x8 q0 = *(const bf16x8*)(ib + (a * 2 + s) * 1024 + lane * 16), q1 = *(const bf16x8*)(ib + (8 + a * 2 + s) * 1024 + lane * 16);
          o0 = MFMA32(q0, sb, o0); o1 = MFMA32(q1, sb, o1); }
      const int tl = otid(), ro = tl & 31, ho = (tl >> 5) & 1;
      bf16_t* ob = OFB + (size_t)dir * T * 1024 + ((size_t)b * 16384 + (size_t)n * 64 + 4 * ho) * 1024 + hd * 256 + wid * 32 + ro;
#pragma unroll
      for (int i = 0; i < 16; ++i) { const int row = (i & 3) + 8 * (i >> 2); ob[(size_t)row * 1024] = f2bf(o0[i]); ob[(size_t)(32 + row) * 1024] = f2bf(o1[i]); }
    }
    if (!OUT || step + 1 < s1) {
      scan_decay(S, c0, c1, h2);
      if (!OUT && wid == 0) { dp0 *= c0; dp1 *= c1; }
#pragma unroll
      for (int s = 0; s < 4; ++s)
#pragma unroll
        for (int a = 0; a < 4; ++a) { bf16x8 ka = *(const bf16x8*)(ib + (16 + s * 4 + a) * 1024 + lane * 16); S[a] = MFMA32(ka, vb[Q][s], S[a]); }
    }
    fetch_v(min(step + 2, s1 - 1), PP);
  };
  fetch(s0, IC<0>{}, true); fetch(min(s0 + 1, s1 - 1), IC<1>{}, true);
#pragma unroll 1
  for (int step = s0; step < s1; step += 2) {
    body(step, IC<0>{});
    if (step + 1 < s1) body(step + 1, IC<1>{});
  }
  __syncthreads();
}
DI void gla_scan_A(const P& p, int u) {
  const int tid = threadIdx.x, wid = tid >> 6, lane = tid & 63;
  const int chain = u >> 4, g = u & 15; if (g == NSEG - 1) return;
  const int b = chain >> 3, hd = (chain >> 1) & 3, dir = chain & 1;
  float* SLOC = (float*)(p.ws + OFF_SLOC); float* DSEG = (float*)(p.ws + OFF_DSEG);
  f32x16 S[4];
#pragma unroll
  for (int a = 0; a < 4; ++a)
#pragma unroll
    for (int i = 0; i < 16; ++i) S[a][i] = 0.f;
  float dp0 = 1.f, dp1 = 1.f;
  const int s0 = g * SEGLEN, s1 = min(s0 + SEGLEN, 260);
  scan_segment<false>(p, S, b, hd, dir, s0, s1, dp0, dp1);
  float* so = SLOC + ((size_t)u * 8 + wid) * 4096 + lane;
#pragma unroll
  for (int a = 0; a < 4; ++a)
#pragma unroll
    for (int i = 0; i < 16; ++i) so[(a * 16 + i) * 64] = S[a][i];
  if (wid == 0) { DSEG[(size_t)u * 128 + lane] = dp0; DSEG[(size_t)u * 128 + 64 + lane] = dp1; }
}
DI void gla_scan_C(const P& p, int u) {
  const int tid = threadIdx.x, wid = tid >> 6, lane = tid & 63, h2 = lane >> 5;
  const int chain = u >> 4, g = u & 15;
  const int b = chain >> 3, hd = (chain >> 1) & 3, dir = chain & 1;
  const float* SLOC = (const float*)(p.ws + OFF_SLOC); const float* DSEG = (const float*)(p.ws + OFF_DSEG);
  f32x16 S[4];
#pragma unroll
  for (int a = 0; a < 4; ++a)
#pragma unroll
    for (int i = 0; i < 16; ++i) S[a][i] = 0.f;
#pragma unroll 1
  for (int gp = 0; gp < g; ++gp) {
    const float* si = SLOC + ((size_t)(chain * 16 + gp) * 8 + wid) * 4096 + lane; const float* dg = DSEG + (size_t)(chain * 16 + gp) * 128;
    const float g0 = dg[lane], g1 = dg[64 + lane];
    float sv[32];
#pragma unroll
    for (int e = 0; e < 32; ++e) sv[e] = si[e * 64];
    scan_decay(S, g0, g1, h2);
#pragma unroll
    for (int hh = 0; hh < 2; ++hh) {
      if (hh) {
#pragma unroll
        for (int e = 0; e < 32; ++e) sv[e] = si[(32 + e) * 64]; }
#pragma unroll
      for (int e = 0; e < 32; ++e) S[hh * 2 + (e >> 4)][e & 15] += sv[e]; }
  }
  float dpa = 1.f, dpb = 1.f;
  const int s0 = g * SEGLEN, s1 = min(s0 + SEGLEN, 260);
  scan_segment<true>(p, S, b, hd, dir, s0, s1, dpa, dpb);
}

DI void phase_global_a(const P& p, int bid, int nb) {
  for (int u = bid; u < 256; u += nb) gla_scan_A(p, u);
  f32x2* G = (f32x2*)(p.ws + OFF_FFTS) + (size_t)bid * 3 * 16384;
  for (int c = bid; c < 1024; c += nb) fft_channel(p, c, G, G + 16384, G + 32768);
}
DI void phase_global_b(const P& p, int bid, int nb) {
  for (int u = bid; u < 256; u += nb) gla_scan_C(p, u);
  const int tid = threadIdx.x; (void)tid;
  bf16_t* W2 = (bf16_t*)(p.ws + OFF_W2);
#pragma unroll 1
  for (int job = 0; job < 6; ++job) {
    const float* src; int ld, K, ncols, dstld, drow0, mode; bf16_t* dst;
    switch (job) {
      case 0: src = p.p_gla; ld = 2048; K = 1024; ncols = 2048; dst = W2 + W2_PM / 2; dstld = 2048; drow0 = 0; mode = 0; break;
      case 1: src = p.p_hy; ld = 2048; K = 1024; ncols = 2048; dst = W2 + W2_PM / 2 + 1024; dstld = 2048; drow0 = 0; mode = 0; break;
      case 2: src = p.w_out; ld = 2048; K = 2048; ncols = 2048; dst = W2 + W2_WOUT / 2; dstld = 2048; drow0 = 0; mode = 0; break;
      case 3: src = p.ffn_gate; ld = 5632; K = 2048; ncols = 5632; dst = W2 + W2_WGU / 2; dstld = 2048; drow0 = 0; mode = 1; break;
      case 4: src = p.ffn_up; ld = 5632; K = 2048; ncols = 5632; dst = W2 + W2_WGU / 2; dstld = 2048; drow0 = 128; mode = 1; break;
      default: src = p.ffn_down; ld = 2048; K = 5632; ncols = 2048; dst = W2 + W2_WD / 2; dstld = 5632; drow0 = 0; mode = 0; break; }
    wconv(src, ld, K, 0, ncols, dst, dstld, drow0, mode, bid, nb);
  }
}

DI void phase_mergeprep(const P& p, int bid, int nb) {
  const int tid = threadIdx.x, wid = tid >> 6, lane = tid & 63;
  bf16_t* AM = (bf16_t*)(p.ws + OFF_AM);
  {
    const bf16_t* O = (const bf16_t*)(p.ws + OFF_O); const bf16_t* G = (const bf16_t*)(p.ws + OFF_G);
    for (int row = bid * 8 + wid; row < T; row += nb * 8) {
      const int c0 = lane * 16; const bf16_t* op = O + (size_t)row * 1024 + c0;
      f32x4 v[4]; float ss = 0.f;
      const bf16_t* ofp = (const bf16_t*)(p.ws + OFF_OFB) + (size_t)row * 1024 + c0; const bf16_t* obp = ofp + (size_t)T * 1024;
      u32x4 f0 = *(const u32x4*)ofp, f1 = *(const u32x4*)(ofp + 8), b0 = *(const u32x4*)obp, b1 = *(const u32x4*)(obp + 8);
      const u32x4 i0 = *(const u32x4*)op, i1 = *(const u32x4*)(op + 8);
#pragma unroll
      for (int q = 0; q < 4; ++q) { const unsigned ia = q < 2 ? i0[2 * (q & 1)] : i1[2 * (q & 1)], ib = q < 2 ? i0[2 * (q & 1) + 1] : i1[2 * (q & 1) + 1];
        v[q] = (f32x4){bflo(ia), bfhi(ia), bflo(ib), bfhi(ib)};
        const unsigned fa = q < 2 ? f0[2 * (q & 1)] : f1[2 * (q & 1)], fb = q < 2 ? f0[2 * (q & 1) + 1] : f1[2 * (q & 1) + 1];
        const unsigned ba = q < 2 ? b0[2 * (q & 1)] : b1[2 * (q & 1)], bb = q < 2 ? b0[2 * (q & 1) + 1] : b1[2 * (q & 1) + 1];
        v[q].x += bflo(fa) + bflo(ba); v[q].y += bfhi(fa) + bfhi(ba); v[q].z += bflo(fb) + bflo(bb); v[q].w += bfhi(fb) + bfhi(bb);
        ss += v[q].x * v[q].x + v[q].y * v[q].y + v[q].z * v[q].z + v[q].w * v[q].w; }
      ss += __shfl_xor(ss, 1, 64); ss += __shfl_xor(ss, 2, 64); ss += __shfl_xor(ss, 4, 64); ss += __shfl_xor(ss, 8, 64);
      const float rstd = rsqrtf(ss * (1.f / 256.f) + 1e-6f);
      const bf16_t* gp = G + (size_t)row * 1024 + c0; u32x4 g0 = *(const u32x4*)gp, g1 = *(const u32x4*)(gp + 8);
      const float* nw = p.gla_norm + (c0 & 255);
      float gv[16];
#pragma unroll
      for (int e = 0; e < 4; ++e) { gv[2 * e] = bflo(g0[e]); gv[2 * e + 1] = bfhi(g0[e]); gv[8 + 2 * e] = bflo(g1[e]); gv[8 + 2 * e + 1] = bfhi(g1[e]); }
      float y[16];
#pragma unroll
      for (int e = 0; e < 16; ++e) y[e] = v[e >> 2][e & 3] * rstd * nw[e] * gv[e];
      u32x4 w0, w1;
      w0.x = pk2(y[0], y[1]); w0.y = pk2(y[2], y[3]); w0.z = pk2(y[4], y[5]); w0.w = pk2(y[6], y[7]);
      w1.x = pk2(y[8], y[9]); w1.y = pk2(y[10], y[11]); w1.z = pk2(y[12], y[13]); w1.w = pk2(y[14], y[15]);
      bf16_t* ap = AM + (size_t)row * 2048 + c0; *(u32x4*)ap = w0; *(u32x4*)(ap + 8) = w1;
    }
  }
  {
    f32x2* tile = (f32x2*)g_smem;
    const bf16_t* ZH = (const bf16_t*)(p.ws + OFF_ZH); const float* ZC = (const float*)(p.ws + OFF_ZC);
    for (int it = bid; it < 4096; it += nb) {
      const int tr = it >> 4, ct = it & 15; const int t0 = tr * 64, c0 = ct * 64;
      { const int c = tid >> 3, t8 = (tid & 7) * 8; const float* s0 = ZC + (size_t)(c0 + c) * 16384 + t0 + t8; const float* s1 = s0 + (size_t)1024 * 16384;
        const f32x4 a0 = *(const f32x4*)s0, a1 = *(const f32x4*)(s0 + 4), b0 = *(const f32x4*)s1, b1 = *(const f32x4*)(s1 + 4);
#pragma unroll
        for (int e = 0; e < 4; ++e) { tile[c * 65 + t8 + e] = (f32x2){a0[e], b0[e]}; tile[c * 65 + t8 + 4 + e] = (f32x2){a1[e], b1[e]}; } }
      __syncthreads();
      const int t = tid >> 3, cg8 = (tid & 7) * 8;
#pragma unroll
      for (int b = 0; b < 2; ++b) {
        float x0[8];
#pragma unroll
        for (int e = 0; e < 8; ++e) x0[e] = p.short_b[c0 + cg8 + e];
#pragma unroll
        for (int tap = 0; tap < 3; ++tap) { const int tt = t + tap - 1; if (tt < 0 || tt > 63) continue;
          u32x4 a = *(const u32x4*)(ZH + ((size_t)b * 16384 + t0 + tt) * 1024 + c0 + cg8);
          const float* w0 = p.short_w + tap * 3072 + c0 + cg8;
#pragma unroll
          for (int e = 0; e < 4; ++e) { x0[2 * e] += bflo(a[e]) * w0[2 * e]; x0[2 * e + 1] += bfhi(a[e]) * w0[2 * e + 1]; } }
        float y[8];
#pragma unroll
        for (int e = 0; e < 8; ++e) { f32x2 yy = tile[(cg8 + e) * 65 + t]; y[e] = (b ? yy.y : yy.x) * x0[e]; }
        u32x4 w; w.x = pk2(y[0], y[1]); w.y = pk2(y[2], y[3]); w.z = pk2(y[4], y[5]); w.w = pk2(y[6], y[7]);
        *(u32x4*)(AM + ((size_t)b * 16384 + t0 + t) * 2048 + 1024 + c0 + cg8) = w;
      }
      __syncthreads();
    }
  }
}

struct MergeSched { const bf16_t* A; const bf16_t* Bt; int bid, nb;
  DI bool next(int i, Unit& u) const { const int L = (i >> 1) * nb + bid; const int part = i & 1; if (L >= 1024) return false; unit_order(L, 128, 8, u.pm, u.pn);
    u.a = (const char*)(A + (size_t)u.pm * 256 * 2048 + part * 1024); u.b = (const char*)(Bt + (size_t)u.pn * 256 * 2048 + part * 1024); u.tag = part; return true; } };
DI void phase_merge(const P& p, int bid, int nb) {
  const bf16_t* AM = (const bf16_t*)(p.ws + OFF_AM); const bf16_t* PM = (const bf16_t*)(p.ws + OFF_W2 + W2_PM);
  const bf16_t* MG = (const bf16_t*)p.out; bf16_t* MERGED = (bf16_t*)(p.ws + OFF_MERGED);
  MergeSched S{AM, PM, bid, nb};
  auto E = [&](f32x4 (&acc)[2][2][4][2], const Unit& u, int wr, int wc, int fr, int fq) {
    const int brow = u.pm * 256, bcol = u.pn * 256;
    if (u.tag == 0) {
#pragma unroll
      for (int ai = 0; ai < 2; ++ai) {
        u32x4 ga[4][2], gb[4][2];
#pragma unroll
        for (int m = 0; m < 4; ++m) { const bf16_t* rp = MG + (size_t)(brow + ai * 128 + wr * 64 + m * 16 + fr) * 4096 + bcol + wc * 32 + 8 * fq;
#pragma unroll
          for (int bj = 0; bj < 2; ++bj) { ga[m][bj] = *(const u32x4*)(rp + bj * 128); gb[m][bj] = *(const u32x4*)(rp + 2048 + bj * 128); } }
        __builtin_amdgcn_sched_barrier(0);
#pragma unroll
        for (int m = 0; m < 4; ++m)
#pragma unroll
          for (int bj = 0; bj < 2; ++bj)
#pragma unroll
            for (int e = 0; e < 4; ++e) { float r0 = (1.f + __expf(-bflo(gb[m][bj][e]))) * __builtin_amdgcn_rcpf(1.f + __expf(-bflo(ga[m][bj][e]))), r1 = (1.f + __expf(-bfhi(gb[m][bj][e]))) * __builtin_amdgcn_rcpf(1.f + __expf(-bfhi(ga[m][bj][e])));
              acc[ai][bj][m][e >> 1][(e & 1) * 2] *= r0; acc[ai][bj][m][e >> 1][(e & 1) * 2 + 1] *= r1; }
      }
    } else {
      u32x4 gb[2][4][2];
#pragma unroll
      for (int ai = 0; ai < 2; ++ai)
#pragma unroll
        for (int m = 0; m < 4; ++m) { const bf16_t* rp = MG + (size_t)(brow + ai * 128 + wr * 64 + m * 16 + fr) * 4096 + 2048 + bcol + wc * 32 + 8 * fq;
#pragma unroll
          for (int bj = 0; bj < 2; ++bj) gb[ai][m][bj] = *(const u32x4*)(rp + bj * 128); }
      __builtin_amdgcn_sched_barrier(0);
#pragma unroll
      for (int ai = 0; ai < 2; ++ai)
#pragma unroll
        for (int m = 0; m < 4; ++m) { const size_t rowi = (size_t)(brow + ai * 128 + wr * 64 + m * 16 + fr);
#pragma unroll
          for (int bj = 0; bj < 2; ++bj) { float o[8];
#pragma unroll
            for (int e = 0; e < 4; ++e) { o[2 * e] = acc[ai][bj][m][e >> 1][(e & 1) * 2] * sigmoidf_(bflo(gb[ai][m][bj][e])); o[2 * e + 1] = acc[ai][bj][m][e >> 1][(e & 1) * 2 + 1] * sigmoidf_(bfhi(gb[ai][m][bj][e])); }
            u32x4 w; w.x = pk2(o[0], o[1]); w.y = pk2(o[2], o[3]); w.z = pk2(o[4], o[5]); w.w = pk2(o[6], o[7]);
            *(u32x4*)(MERGED + rowi * 2048 + bcol + bj * 128 + wc * 32 + 8 * fq) = w; } }
    }
  };
  gemm_stream(2048, 2048, 1024, S, E);
}

DI void phase_wout(const P& p, int bid, int nb) {
  const bf16_t* MERGED = (const bf16_t*)(p.ws + OFF_MERGED); const bf16_t* WO = (const bf16_t*)(p.ws + OFF_W2 + W2_WOUT); bf16_t* MIX = (bf16_t*)(p.ws + OFF_MIX);
  GridSched S{MERGED, WO, 2048, 2048, 128, 8, bid, nb};
  auto E = [&](f32x4 (&acc)[2][2][4][2], const Unit& u, int wr, int wc, int fr, int fq) { store_tile_bf16<0>(acc, MIX, 2048, u.pm * 256, u.pn * 256, 1.f, wr, wc, fr, fq); };
  gemm_stream(2048, 2048, 2048, S, E);
}

DI void phase_rowmid(const P& p, int bid, int nb) {
  const int tid = threadIdx.x, wid = tid >> 6, lane = tid & 63;
  const float* MOD = (const float*)(p.ws + OFF_MOD); const bf16_t* MIX = (const bf16_t*)(p.ws + OFF_MIX); bf16_t* HX2 = (bf16_t*)(p.ws + OFF_HX2); bf16_t* X1B = (bf16_t*)(p.ws + OFF_MIX);
  for (int row = bid * 8 + wid; row < T; row += nb * 8) {
    const float* md = MOD + (row >> 14) * 12288;
    float mv[32]; float ss = 0.f;
#pragma unroll
    for (int q = 0; q < 4; ++q) { u32x4 a = *(const u32x4*)(MIX + (size_t)row * 2048 + q * 512 + lane * 8);
#pragma unroll
      for (int e = 0; e < 4; ++e) { mv[q * 8 + 2 * e] = bflo(a[e]); mv[q * 8 + 2 * e + 1] = bfhi(a[e]); } }
#pragma unroll
    for (int e = 0; e < 32; ++e) ss += mv[e] * mv[e];
    ss = wave_sum(ss); const float rstd = rsqrtf(ss * (1.f / 2048.f) + 1e-6f);
    float ss2 = 0.f;
#pragma unroll
    for (int q = 0; q < 4; ++q)
#pragma unroll
      for (int hh = 0; hh < 2; ++hh) { const int idx = q * 512 + lane * 8 + hh * 4;
        f32x4 xv = *(const f32x4*)(p.x + (size_t)row * 2048 + idx), w = *(const f32x4*)(p.n_post_mix + idx), g1 = *(const f32x4*)(md + 4096 + idx);
#pragma unroll
        for (int e = 0; e < 4; ++e) { float x1 = xv[e] + g1[e] * (mv[q * 8 + hh * 4 + e] * rstd * w[e]); mv[q * 8 + hh * 4 + e] = x1; ss2 += x1 * x1; } }
    ss2 = wave_sum(ss2); const float rstd2 = rsqrtf(ss2 * (1.f / 2048.f) + 1e-6f);
#pragma unroll
    for (int q = 0; q < 4; ++q) { const int idx = q * 512 + lane * 8; float y[8];
#pragma unroll
      for (int hh = 0; hh < 2; ++hh) { f32x4 w = *(const f32x4*)(p.n_pre_ffn + idx + hh * 4), s2 = *(const f32x4*)(md + 8192 + idx + hh * 4), h2 = *(const f32x4*)(md + 6144 + idx + hh * 4);
#pragma unroll
        for (int e = 0; e < 4; ++e) y[hh * 4 + e] = mv[q * 8 + hh * 4 + e] * rstd2 * w[e] * (1.f + s2[e]) + h2[e]; }
      u32x4 o; o.x = pk2(y[0], y[1]); o.y = pk2(y[2], y[3]); o.z = pk2(y[4], y[5]); o.w = pk2(y[6], y[7]);
      *(u32x4*)(HX2 + (size_t)row * 2048 + idx) = o;
      u32x4 xo; xo.x = pk2(mv[q * 8], mv[q * 8 + 1]); xo.y = pk2(mv[q * 8 + 2], mv[q * 8 + 3]); xo.z = pk2(mv[q * 8 + 4], mv[q * 8 + 5]); xo.w = pk2(mv[q * 8 + 6], mv[q * 8 + 7]);
      *(u32x4*)(X1B + (size_t)row * 2048 + idx) = xo; }
  }
}

DI void phase_ffn1(const P& p, int bid, int nb) {
  const bf16_t* HX2 = (const bf16_t*)(p.ws + OFF_HX2); const bf16_t* WGU = (const bf16_t*)(p.ws + OFF_W2 + W2_WGU); bf16_t* HID = (bf16_t*)(p.ws + OFF_HID);
  GridSched S{HX2, WGU, 2048, 2048, 128, 44, bid, nb};
  auto E = [&](f32x4 (&acc)[2][2][4][2], const Unit& u, int wr, int wc, int fr, int fq) {
#pragma unroll
    for (int ai = 0; ai < 2; ++ai)
#pragma unroll
      for (int m = 0; m < 4; ++m) { float o[8];
#pragma unroll
        for (int n = 0; n < 2; ++n)
#pragma unroll
          for (int jx = 0; jx < 4; ++jx) { float gte = acc[ai][0][m][n][jx], up = acc[ai][1][m][n][jx]; o[n * 4 + jx] = gte * sigmoidf_(gte) * up; }
        u32x4 w; w.x = pk2(o[0], o[1]); w.y = pk2(o[2], o[3]); w.z = pk2(o[4], o[5]); w.w = pk2(o[6], o[7]);
        *(u32x4*)(HID + (size_t)(u.pm * 256 + ai * 128 + wr * 64 + m * 16 + fr) * 5632 + u.pn * 128 + wc * 32 + 8 * fq) = w; }
  };
  gemm_stream(2048, 2048, 2048, S, E);
}
DI void phase_ffn2(const P& p, int bid, int nb) {
  const bf16_t* HID = (const bf16_t*)(p.ws + OFF_HID); const bf16_t* WD = (const bf16_t*)(p.ws + OFF_W2 + W2_WD); bf16_t* FFN = (bf16_t*)(p.ws + OFF_FFN);
  GridSched S{HID, WD, 5632, 5632, 128, 8, bid, nb};
  auto E = [&](f32x4 (&acc)[2][2][4][2], const Unit& u, int wr, int wc, int fr, int fq) { store_tile_bf16<0>(acc, FFN, 2048, u.pm * 256, u.pn * 256, 1.f, wr, wc, fr, fq); };
  gemm_stream(5632, 5632, 5632, S, E);
}
DI void phase_final(const P& p, int bid, int nb) {
  const int tid = threadIdx.x, wid = tid >> 6, lane = tid & 63;
  const float* MOD = (const float*)(p.ws + OFF_MOD); const bf16_t* FFN = (const bf16_t*)(p.ws + OFF_FFN); const bf16_t* X1B = (const bf16_t*)(p.ws + OFF_MIX);
  for (int row = bid * 8 + wid; row < T; row += nb * 8) {
    const float* md = MOD + (row >> 14) * 12288;
    float mv[32]; float ss = 0.f;
#pragma unroll
    for (int q = 0; q < 4; ++q) { u32x4 a = *(const u32x4*)(FFN + (size_t)row * 2048 + q * 512 + lane * 8);
#pragma unroll
      for (int e = 0; e < 4; ++e) { mv[q * 8 + 2 * e] = bflo(a[e]); mv[q * 8 + 2 * e + 1] = bfhi(a[e]); } }
#pragma unroll
    for (int e = 0; e < 32; ++e) ss += mv[e] * mv[e];
    ss = wave_sum(ss); const float rstd = rsqrtf(ss * (1.f / 2048.f) + 1e-6f);
#pragma unroll
    for (int q = 0; q < 4; ++q)
#pragma unroll
      for (int hh = 0; hh < 2; ++hh) { const int idx = q * 512 + lane * 8 + hh * 4;
        const u32x2 xb = *(const u32x2*)(X1B + (size_t)row * 2048 + idx);
        f32x4 xv = {bflo(xb.x), bfhi(xb.x), bflo(xb.y), bfhi(xb.y)}, w = *(const f32x4*)(p.n_post_ffn + idx), g2 = *(const f32x4*)(md + 10240 + idx);
#pragma unroll
        for (int e = 0; e < 4; ++e) xv[e] += g2[e] * (mv[q * 8 + hh * 4 + e] * rstd * w[e]);
        *(f32x4*)(p.out + (size_t)row * 2048 + idx) = xv; }
  }
}

constexpr int NPHASE = 13;
#define RUN_PH(k, call) do { if (ph_lo <= (k) && (k) < ph_hi) { if ((k) > ph_lo) grid.sync(); call; } } while (0)
__global__ void __launch_bounds__(NTHREADS) hybrid_layer_kernel(P p, int ph_lo, int ph_hi) {
  cg::grid_group grid = cg::this_grid();
  const int bid = blockIdx.x, nb = gridDim.x;
  RUN_PH(0, phase_prep(p, bid, nb));
  RUN_PH(1, phase_pre(p, bid, nb));
  RUN_PH(2, phase_gemm1(p, bid, nb));
  RUN_PH(3, phase_local(p, bid, nb));
  RUN_PH(4, phase_global_a(p, bid, nb));
  RUN_PH(5, phase_global_b(p, bid, nb));
  RUN_PH(6, phase_mergeprep(p, bid, nb));
  RUN_PH(7, phase_merge(p, bid, nb));
  RUN_PH(8, phase_wout(p, bid, nb));
  RUN_PH(9, phase_rowmid(p, bid, nb));
  RUN_PH(10, phase_ffn1(p, bid, nb));
  RUN_PH(11, phase_ffn2(p, bid, nb));
  RUN_PH(12, phase_final(p, bid, nb));
}

extern "C" void kernel_launch(void* const* d_in, const int* in_sizes, int n_in, void* d_out, int out_size, void* d_ws, size_t ws_size, hipStream_t stream) {
  (void)in_sizes; (void)n_in; (void)out_size;
  if (ws_size < WS_NEEDED) { fprintf(stderr, "workspace too small: %zu < %zu\n", ws_size, (size_t)WS_NEEDED); return; }
  P p{};
  const float** f = (const float**)&p;
  for (int i = 0; i < 31; ++i) f[i] = (const float*)d_in[i];
  p.out = (float*)d_out; p.ws = (char*)d_ws;
  static int grid_blocks = 0;
  if (!grid_blocks) {
    hipFuncSetAttribute((const void*)hybrid_layer_kernel, hipFuncAttributeMaxDynamicSharedMemorySize, SMEM_BYTES);
    int dev = 0, cus = 0, per_cu = 0;
    hipGetDevice(&dev);
    hipDeviceGetAttribute(&cus, hipDeviceAttributeMultiprocessorCount, dev);
    hipOccupancyMaxActiveBlocksPerMultiprocessor(&per_cu, hybrid_layer_kernel, NTHREADS, SMEM_BYTES);
    if (per_cu < 1) per_cu = 1;
    grid_blocks = cus * 1;
  }
#if SINGLE_LAUNCH
  int lo = 0, hi = NPHASE;
  void* args[] = {&p, &lo, &hi};
  hipError_t e = hipLaunchCooperativeKernel((void*)hybrid_layer_kernel, dim3(grid_blocks), dim3(NTHREADS), args, SMEM_BYTES, stream);
  if (e != hipSuccess) fprintf(stderr, "cooperative launch failed: %s (grid %d)\n", hipGetErrorString(e), grid_blocks);
#else
  for (int ph = 0; ph < NPHASE; ++ph) hybrid_layer_kernel<<<grid_blocks, NTHREADS, SMEM_BYTES, stream>>>(p, ph, ph + 1);
#endif
}
```
